# Optimizing an MI355X kernel written in HIP

```python
import jax, jax.numpy as jnp
from jax import lax
import numpy as np

D_MODEL = 1024
BATCH = 8
SEQ = 4096
DEPTH = 2

CTX_LEN = 256
GRID_W = 64
A_CHUNK = 2 * GRID_W
A_WIDTH = D_MODEL
A_GROUPS = 8
A_GROUP_DIM = A_WIDTH // A_GROUPS
GLA_HEADS = 4
GLA_DK = D_MODEL // 2
GLA_DV = D_MODEL
GLA_HEAD_K = GLA_DK // GLA_HEADS
GLA_HEAD_V = GLA_DV // GLA_HEADS
GLA_GATE_RANK = 16
GLA_TAU = 16.0
GLA_CHUNK = 64
N_EXPERTS = 16
N_EXPERT_GROUPS = 4
EXPERTS_PER_GROUP = N_EXPERTS // N_EXPERT_GROUPS
TOP_K = 2
D_EXPERT = 3 * D_MODEL // 2
MOE_BLOCK = 128
EPS = 1e-6
IN_SIZES = (2 * A_WIDTH, GLA_DK, GLA_DK, GLA_DV, GLA_DV, GLA_GATE_RANK, GLA_GATE_RANK, 2 * D_MODEL)
IN_COLS = sum(IN_SIZES)

kernel_name = "hybrid_gmlp_gla_moe_diffusion_block"


def rms_norm(x, g):
    xf = x.astype(jnp.float32)
    y = xf * lax.rsqrt(jnp.mean(xf * xf, axis=-1, keepdims=True) + EPS)
    return (y * g.astype(jnp.float32)).astype(x.dtype)


def layer_norm(x, g, b):
    xf = x.astype(jnp.float32)
    mu = jnp.mean(xf, axis=-1, keepdims=True)
    xc = xf - mu
    y = xc * lax.rsqrt(jnp.mean(xc * xc, axis=-1, keepdims=True) + EPS)
    return (y * g.astype(jnp.float32) + b.astype(jnp.float32)).astype(x.dtype)


def split_cols(p):
    idx, acc = [], 0
    for s in IN_SIZES[:-1]:
        acc += s
        idx.append(acc)
    return jnp.split(p, idx, axis=-1)


def spatial_gating(z, ln_g, ln_b, w_s, b_s):
    u, v = jnp.split(z, 2, axis=-1)
    v = layer_norm(v, ln_g, ln_b)
    bsz, length, width = v.shape
    vr = v.reshape(bsz, length // A_CHUNK, A_CHUNK, A_GROUPS, A_GROUP_DIM)
    mixed = jnp.einsum('gts,bnsgc->bntgc', w_s, vr) + b_s.T[:, :, None]
    return u * mixed.reshape(bsz, length, width)


def gla_chunk_scan(q, k, v, log_a, s0):
    bsz, nh, length, _ = q.shape
    dv = v.shape[-1]
    n = length // GLA_CHUNK
    cs = lambda t: t.astype(jnp.float32).reshape(bsz, nh, n, GLA_CHUNK, t.shape[-1])
    q, k, v, log_a = cs(q), cs(k), cs(v), cs(log_a)
    b = jnp.cumsum(log_a, axis=-2)
    b_last = b[..., -1:, :]
    q_in = q * jnp.exp(b)
    k_in = k * jnp.exp(-b)
    k_st = k * jnp.exp(b_last - b)
    mask = jnp.tril(jnp.ones((GLA_CHUNK, GLA_CHUNK), dtype=bool))
    att = jnp.where(mask, jnp.einsum('bhntk,bhnsk->bhnts', q_in, k_in), 0.0)
    o_intra = jnp.einsum('bhnts,bhnsv->bhntv', att, v)

    def step(state, xs):
        qc, kc, vc, dc = xs
        o = jnp.einsum('bhtk,bhkv->bhtv', qc, state)
        state = dc[..., 0, :, None] * state + jnp.einsum('bhsk,bhsv->bhkv', kc, vc)
        return state, o

    xs = tuple(jnp.moveaxis(t, 2, 0) for t in (q_in, k_st, v, jnp.exp(b_last)))
    s_fin, o_inter = lax.scan(step, s0, xs)
    o = o_intra + jnp.moveaxis(o_inter, 0, 2)
    return o.reshape(bsz, nh, length, dv), s_fin


def gla_bidirectional(q, k, v, la_f, la_b, s_f, s_b):
    o_f, s_f = gla_chunk_scan(q, k, v, la_f, s_f)
    flip = lambda t: jnp.flip(t, axis=2)
    o_b, s_b = gla_chunk_scan(flip(q), flip(k), flip(v), flip(la_b), s_b)
    return o_f + flip(o_b), s_f, s_b


def token_mixer(h_x, h_c, w_in, w_gate2, b_gate2, gla_g, sgu_ln_g, sgu_ln_b, sgu_w, sgu_b,
                w_a, w_b, b_branch, w_out, with_ctx):
    parts_x = split_cols(h_x @ w_in)
    parts_c = split_cols(h_c @ w_in)

    def heads(t):
        bsz, length, width = t.shape
        return t.reshape(bsz, length, GLA_HEADS, width // GLA_HEADS).transpose(0, 2, 1, 3)

    def gla_inputs(parts):
        _, q, k, v, _, lr_f, lr_b, _ = parts
        la = [heads(jax.nn.log_sigmoid((lr @ w_gate2[d] + b_gate2[d]).astype(jnp.float32)) / GLA_TAU)
              for d, lr in enumerate((lr_f, lr_b))]
        return heads(q) * GLA_HEAD_K ** -0.5, heads(k), heads(v), la[0], la[1]

    zero = jnp.zeros((h_c.shape[0], GLA_HEADS, GLA_HEAD_K, GLA_HEAD_V), jnp.float32)
    o_c, s_f, s_b = gla_bidirectional(*gla_inputs(parts_c), zero, zero)
    o_x, _, _ = gla_bidirectional(*gla_inputs(parts_x), s_f, s_b)

    def merge(parts, o):
        z_a, _, _, _, r, _, _, gates = parts
        y_a = spatial_gating(jax.nn.gelu(z_a), sgu_ln_g, sgu_ln_b, sgu_w, sgu_b) @ w_a
        o_n = o * lax.rsqrt(jnp.mean(o * o, axis=-1, keepdims=True) + EPS)
        bsz, _, length, _ = o.shape
        o_n = o_n.transpose(0, 2, 1, 3).reshape(bsz, length, GLA_DV) * gla_g
        y_b = (o_n.astype(r.dtype) * jax.nn.silu(r)) @ w_b
        g_a, g_b = jnp.split(jax.nn.sigmoid(gates + b_branch), 2, axis=-1)
        return (g_a * y_a + g_b * y_b) @ w_out

    y_x = merge(parts_x, o_x)
    y_c = merge(parts_c, o_c) if with_ctx else None
    return y_x, y_c


def moe_ffn(h, w_router, b_router, w_g, w_u, w_d):
    n_tok, d = h.shape
    logits = h.astype(jnp.float32) @ w_router.astype(jnp.float32) + b_router.astype(jnp.float32)
    probs = jax.nn.softmax(logits, axis=-1).reshape(n_tok, N_EXPERT_GROUPS, EXPERTS_PER_GROUP)
    group_score = lax.top_k(probs, TOP_K)[0].sum(-1)
    g_sel = jnp.argmax(group_score, axis=-1)
    in_group = jnp.take_along_axis(probs, g_sel[:, None, None], axis=1)[:, 0]
    top_w, top_i = lax.top_k(in_group, TOP_K)
    weight = top_w / jnp.sum(top_w, axis=-1, keepdims=True)
    expert = (g_sel[:, None] * EXPERTS_PER_GROUP + top_i).reshape(-1).astype(jnp.int32)

    n_slot = n_tok * TOP_K
    token = jnp.repeat(jnp.arange(n_tok, dtype=jnp.int32), TOP_K)
    order = jnp.argsort(expert)
    e_sorted = expert[order]
    counts = jnp.bincount(expert, length=N_EXPERTS).astype(jnp.int32)
    starts = jnp.cumsum(counts) - counts
    padded = (counts + MOE_BLOCK - 1) // MOE_BLOCK * MOE_BLOCK
    p_ends = jnp.cumsum(padded)
    p_starts = p_ends - padded
    dest_sorted = p_starts[e_sorted] + jnp.arange(n_slot, dtype=jnp.int32) - starts[e_sorted]
    n_blocks = -(-n_slot // MOE_BLOCK) + N_EXPERTS
    buf_tok = jnp.full((n_blocks * MOE_BLOCK,), n_tok, jnp.int32).at[dest_sorted].set(token[order])
    block_e = jnp.minimum(jnp.searchsorted(p_ends, jnp.arange(n_blocks, dtype=jnp.int32) * MOE_BLOCK,
                                           side='right'), N_EXPERTS - 1)
    h_pad = jnp.concatenate([h, jnp.zeros((1, d), h.dtype)], axis=0)
    x_blk = h_pad[buf_tok].reshape(n_blocks, MOE_BLOCK, d)

    def expert_block(args):
        xb, e = args
        return (jax.nn.silu(xb @ w_g[e]) * (xb @ w_u[e])) @ w_d[e]

    y_blk = lax.map(expert_block, (x_blk, block_e)).reshape(-1, d)
    dest = jnp.zeros((n_slot,), jnp.int32).at[order].set(dest_sorted)
    y = y_blk[dest].reshape(n_tok, TOP_K, d) * weight[..., None].astype(h.dtype)
    return jnp.sum(y, axis=1)


def setup_inputs(seed: int = 0) -> dict:
    key = jax.random.key(seed)
    ks = iter(jax.random.split(key, 32))
    nrm = lambda shape, std: jax.random.normal(next(ks), shape, jnp.float32) * std
    L = DEPTH
    return {
        "x": nrm((BATCH, SEQ, D_MODEL), 1.0),
        "c": nrm((BATCH, D_MODEL), 1.0),
        "ctx": nrm((BATCH, CTX_LEN, D_MODEL), 1.0),
        "c_ctx": nrm((D_MODEL,), 1.0),
        "w_mod": nrm((L, D_MODEL, 6 * D_MODEL), 0.5 * D_MODEL ** -0.5),
        "b_mod": nrm((L, 6 * D_MODEL), 0.01),
        "g_norm1": 1.0 + nrm((L, D_MODEL), 0.01),
        "g_norm2": 1.0 + nrm((L, D_MODEL), 0.01),
        "w_in": nrm((L, D_MODEL, IN_COLS), D_MODEL ** -0.5),
        "w_gate2": nrm((L, 2, GLA_GATE_RANK, GLA_DK), GLA_GATE_RANK ** -0.5),
        "b_gate2": nrm((L, 2, GLA_DK), 0.1),
        "gla_norm_g": 1.0 + nrm((L, GLA_DV), 0.01),
        "sgu_ln_g": 1.0 + nrm((L, A_WIDTH), 0.01),
        "sgu_ln_b": nrm((L, A_WIDTH), 0.01),
        "sgu_w": nrm((L, A_GROUPS, A_CHUNK, A_CHUNK), A_CHUNK ** -0.5),
        "sgu_b": 1.0 + nrm((L, A_GROUPS, A_CHUNK), 0.01),
        "w_branch_a": nrm((L, A_WIDTH, D_MODEL), A_WIDTH ** -0.5),
        "w_branch_b": nrm((L, GLA_DV, D_MODEL), GLA_DV ** -0.5),
        "b_branch": nrm((L, 2 * D_MODEL), 0.01),
        "w_out": nrm((L, D_MODEL, D_MODEL), D_MODEL ** -0.5),
        "w_router": nrm((D_MODEL, N_EXPERTS), D_MODEL ** -0.5),
        "b_router": nrm((N_EXPERTS,), 0.01),
        "w_exp_gate": nrm((L, N_EXPERTS, D_MODEL, D_EXPERT), D_MODEL ** -0.5),
        "w_exp_up": nrm((L, N_EXPERTS, D_MODEL, D_EXPERT), D_MODEL ** -0.5),
        "w_exp_down": nrm((L, N_EXPERTS, D_EXPERT, D_MODEL), D_EXPERT ** -0.5),
        "g_final": 1.0 + nrm((D_MODEL,), 0.01),
    }


def reference(x, c, ctx, c_ctx, w_mod, b_mod, g_norm1, g_norm2, w_in, w_gate2, b_gate2, gla_norm_g,
              sgu_ln_g, sgu_ln_b, sgu_w, sgu_b, w_branch_a, w_branch_b, b_branch, w_out,
              w_router, b_router, w_exp_gate, w_exp_up, w_exp_down, g_final):
    bsz, seq, d = x.shape
    n_lat = bsz * seq
    for layer in range(DEPTH):
        with_ctx = layer < DEPTH - 1
        mod_x = (jax.nn.silu(c) @ w_mod[layer] + b_mod[layer])[:, None, :]
        mod_c = jax.nn.silu(c_ctx) @ w_mod[layer] + b_mod[layer]
        sh1, sc1, gt1, sh2, sc2, gt2 = jnp.split(mod_x, 6, axis=-1)
        csh1, csc1, cgt1, csh2, csc2, cgt2 = jnp.split(mod_c, 6, axis=-1)

        h_x = rms_norm(x, g_norm1[layer]) * (1.0 + sc1) + sh1
        h_c = rms_norm(ctx, g_norm1[layer]) * (1.0 + csc1) + csh1
        y_x, y_c = token_mixer(h_x, h_c, w_in[layer], w_gate2[layer], b_gate2[layer], gla_norm_g[layer],
                               sgu_ln_g[layer], sgu_ln_b[layer], sgu_w[layer], sgu_b[layer],
                               w_branch_a[layer], w_branch_b[layer], b_branch[layer], w_out[layer], with_ctx)
        x = x + gt1 * y_x

        tokens = (rms_norm(x, g_norm2[layer]) * (1.0 + sc2) + sh2).reshape(-1, d)
        if with_ctx:
            ctx = ctx + cgt1 * y_c
            h_c2 = rms_norm(ctx, g_norm2[layer]) * (1.0 + csc2) + csh2
            tokens = jnp.concatenate([tokens, h_c2.reshape(-1, d)], axis=0)
        y = moe_ffn(tokens, w_router, b_router, w_exp_gate[layer], w_exp_up[layer], w_exp_down[layer])
        x = x + gt2 * y[:n_lat].reshape(bsz, seq, d)
        if with_ctx:
            ctx = ctx + cgt2 * y[n_lat:].reshape(ctx.shape)
    return rms_norm(x, g_final)
```

```cpp
#include <hip/hip_runtime.h>
#include <cstdio>
#include <cstdint>

#ifndef MK_SPLIT
#define MK_SPLIT 0
#endif

namespace pg8 {
#define PG8_LAS __attribute__((address_space(3)))
typedef unsigned short bf16_t;
typedef short bf16x8 __attribute__((ext_vector_type(8)));
typedef float f32x4 __attribute__((ext_vector_type(4)));
typedef float f32x2 __attribute__((ext_vector_type(2)));
typedef unsigned u32x4 __attribute__((ext_vector_type(4)));
constexpr int BM = 256, BK = 64, HALF = 128, HTB = HALF * BK * 2, STAGE_BYTES = 8 * HTB, NXCD = 8, WGM = 8;

__host__ __device__ __forceinline__ int lds_byte(int r, int c) { const int st = (r >> 4) * 2 + (c >> 5), rr = r & 15, cc = c & 31, ob = rr * 64 + cc * 2; return st * 1024 + (ob ^ (((ob >> 9) & 1) << 5)); }
__host__ __device__ __forceinline__ void stage_rc(int b, int& R, int& C) { const int st = b / 1024, sb = b % 1024, swz = sb ^ (((sb >> 9) & 1) << 5); R = (st >> 1) * 16 + swz / 64; C = (st & 1) * 32 + (swz % 64) / 2; }
__host__ __device__ __forceinline__ int perm32(int rho) { const int n = rho >> 4, i = rho & 15; return 8 * (i >> 2) + 4 * n + (i & 3); }

struct Unit { int pm, pn, sub, e; const char* a; const char* b; };

struct StaticOrder {
    int nM, nN, nwg, G, c;
    __device__ __forceinline__ void init(int nM_, int nN_, int G_, int c_) { nM = nM_; nN = nN_; nwg = nM * nN; G = G_; c = c_; }
    __device__ __forceinline__ bool tile(int i, int& pm, int& pn) const {
        const long L = (long)i * G + c; if (L >= nwg) return false;
        int wgid = (int)L; { const int q = nwg / NXCD, r = nwg % NXCD, xcd = wgid % NXCD, off = wgid / NXCD; wgid = (xcd < r ? xcd * (q + 1) : r * (q + 1) + (xcd - r) * q) + off; }
        const int nig = WGM * nN, gid = wgid / nig, fm = gid * WGM, gsz = (nM - fm) < WGM ? (nM - fm) : WGM;
        pm = fm + ((wgid % nig) % gsz); pn = (wgid % nig) / gsz; return true;
    }
};
struct SchedPlain {
    StaticOrder o; const char* A; const char* B; size_t tstep;
    __device__ __forceinline__ bool next(int i, Unit& u) const { if (!o.tile(i, u.pm, u.pn)) return false; u.sub = 0; u.e = 0; u.a = A + (size_t)u.pm * tstep; u.b = B + (size_t)u.pn * tstep; return true; }
};
struct SchedDual {
    StaticOrder o; const char* A0; const char* B0; const char* A1; const char* B1; size_t tstep;
    __device__ __forceinline__ bool next(int i, Unit& u) const { if (!o.tile(i >> 1, u.pm, u.pn)) return false; u.sub = i & 1; u.e = 0;
        u.a = (u.sub ? A1 : A0) + (size_t)u.pm * tstep; u.b = (u.sub ? B1 : B0) + (size_t)u.pn * tstep; return true; }
};
struct SchedMoe {
    StaticOrder o; const char* A; const char* B; size_t tstep; size_t estride; const int* tile_e;
    __device__ __forceinline__ bool next(int i, Unit& u) const { if (!o.tile(i, u.pm, u.pn)) return false; u.sub = 0; u.e = tile_e[u.pm];
        u.a = A + (size_t)u.pm * tstep; u.b = B + (size_t)u.e * estride + (size_t)u.pn * tstep; return true; }
};

__device__ __forceinline__ unsigned cvt_pk_bf16(float lo, float hi) { unsigned r; asm volatile("v_cvt_pk_bf16_f32 %0, %1, %2" : "=v"(r) : "v"(lo), "v"(hi)); return r; }

template <class Epi, class Sched, bool ALIGN_EPI, bool SP2>
__device__ __forceinline__ void gemm_phase(PG8_LAS unsigned char* lds, const int K, const Sched& S, const Epi& E) {
    int tid_ = threadIdx.x; asm volatile("" : "+v"(tid_)); const int tid = tid_, wid = __builtin_amdgcn_readfirstlane(tid >> 6), lane = tid & 63, wr = wid >> 2, wc = wid & 3, fr = lane & 15, fq = lane >> 4;
    const int nt = K / BK;
    unsigned voffA[2], voffB[2];
#pragma unroll
    for (int i = 0; i < 2; ++i) { int R, C; stage_rc(tid * 16 + i * 8192, R, C); const int Rb = Epi::PERM ? ((R & ~31) + perm32(R & 31)) : R;
        voffA[i] = (unsigned)(R * K + C) * 2u; voffB[i] = (unsigned)(Rb * K + C) * 2u; }
    const size_t kstep = (size_t)(BK * 2);
    const size_t hstep = (size_t)HALF * K * 2;
    const unsigned ldsw = (unsigned)wid * 1024u;
    const int aoff = lds_byte(wr * 64 + fr, fq * 8), boff = lds_byte(wc * 32 + fr, fq * 8);
#define PG8_SA(b, h) (((b) * 2 + (h)) * HTB)
#define PG8_SB(b, h) ((4 + (b) * 2 + (h)) * HTB)
#define PG8_STAGE(bufoff, gbase, voff) do { _Pragma("unroll") for (int _i = 0; _i < 2; ++_i) \
        __builtin_amdgcn_global_load_lds((const unsigned*)((const char*)(gbase) + (voff)[_i]), (PG8_LAS unsigned*)(lds + (bufoff) + ldsw + _i * 8192), 16, 0, 0); } while (0)
#define PG8_LDA(dst, b, h) do { _Pragma("unroll") for (int m = 0; m < 4; ++m) _Pragma("unroll") for (int k = 0; k < 2; ++k) dst[m][k] = *(const PG8_LAS bf16x8*)(lds + PG8_SA(b, h) + aoff + m * 2048 + k * 1024); } while (0)
#define PG8_LDB(dst, b, h) do { _Pragma("unroll") for (int n = 0; n < 2; ++n) _Pragma("unroll") for (int k = 0; k < 2; ++k) dst[n][k] = *(const PG8_LAS bf16x8*)(lds + PG8_SB(b, h) + boff + n * 2048 + k * 1024); } while (0)
#define PG8_MMA(ai, bj, At, Bt) do { __builtin_amdgcn_s_setprio(1); _Pragma("unroll") for (int m = 0; m < 4; ++m) _Pragma("unroll") for (int n = 0; n < 2; ++n) _Pragma("unroll") for (int k = 0; k < 2; ++k) \
        acc[ai][bj][m][n] = __builtin_amdgcn_mfma_f32_16x16x32_bf16(Bt[n][k], At[m][k], acc[ai][bj][m][n], 0, 0, 0); __builtin_amdgcn_s_setprio(0); } while (0)
#define PG8_WAIT_V(n) asm volatile("s_waitcnt vmcnt(" #n ")" ::: "memory")
#define PG8_WAIT_L(n) asm volatile("s_waitcnt lgkmcnt(" #n ")" ::: "memory")
#define PG8_BAR __builtin_amdgcn_s_barrier()
#define PG8_SCHED __builtin_amdgcn_sched_barrier(0)
    Unit cur, nxt; int ui = 0;
    if (!S.next(0, cur)) return;
    f32x4 acc[2][2][4][2];
#pragma unroll
    for (int a = 0; a < 2; ++a)
#pragma unroll
        for (int b = 0; b < 2; ++b)
#pragma unroll
            for (int m = 0; m < 4; ++m)
#pragma unroll
                for (int n = 0; n < 2; ++n) acc[a][b][m][n] = (f32x4){0.f, 0.f, 0.f, 0.f};
    bf16x8 At[4][2], B0[2][2], B1[2][2];
    const char* cA = cur.a; const char* cB = cur.b;
    if constexpr (SP2) {
        PG8_STAGE(PG8_SB(0, 0), cB, voffB); PG8_STAGE(PG8_SB(0, 1), cB + hstep, voffB); PG8_STAGE(PG8_SA(0, 0), cA, voffA); PG8_STAGE(PG8_SA(0, 1), cA + hstep, voffA);
        if (wr == 1) PG8_BAR;
        PG8_WAIT_V(2); PG8_BAR;
        PG8_STAGE(PG8_SB(1, 0), cB + kstep, voffB); PG8_STAGE(PG8_SA(1, 0), cA + kstep, voffA); PG8_STAGE(PG8_SB(1, 1), cB + hstep + kstep, voffB);
        PG8_WAIT_V(6); PG8_BAR;
    } else {
        PG8_STAGE(PG8_SB(0, 0), cB, voffB); PG8_STAGE(PG8_SA(0, 0), cA, voffA); PG8_STAGE(PG8_SB(0, 1), cB + hstep, voffB); PG8_STAGE(PG8_SA(0, 1), cA + hstep, voffA);
        if (wr == 1) PG8_BAR;
        PG8_WAIT_V(4); PG8_BAR;
        PG8_STAGE(PG8_SB(1, 0), cB + kstep, voffB); PG8_STAGE(PG8_SA(1, 0), cA + kstep, voffA); PG8_STAGE(PG8_SB(1, 1), cB + hstep + kstep, voffB);
        PG8_WAIT_V(6); PG8_BAR;
    }
    for (;;) {
        const bool has_next = S.next(ui + 1, nxt);
        const char* nA = has_next ? nxt.a : cA; const char* nB = has_next ? nxt.b : cB;
        for (int t = 0; t < nt; t += 2) {
            const bool last = (t == nt - 2);
            const char* a1 = cA + (size_t)(t + 1) * kstep;
            const char* a2 = last ? nA : cA + (size_t)(t + 2) * kstep; const char* b2 = last ? nB : cB + (size_t)(t + 2) * kstep;
            const char* a3 = a2 + kstep; const char* b3 = b2 + kstep;
            if constexpr (SP2) {
            PG8_LDB(B0, 0, 0); PG8_LDB(B1, 0, 1); PG8_SCHED; PG8_LDA(At, 0, 0); PG8_STAGE(PG8_SA(1, 1), a1 + hstep, voffA);
            PG8_WAIT_V(8); PG8_WAIT_L(0); PG8_BAR; PG8_MMA(0, 0, At, B0); PG8_MMA(0, 1, At, B1); PG8_BAR; PG8_SCHED;
            PG8_LDA(At, 0, 1); PG8_STAGE(PG8_SB(0, 0), b2, voffB); PG8_STAGE(PG8_SB(0, 1), b2 + hstep, voffB); PG8_STAGE(PG8_SA(0, 0), a2, voffA);
            PG8_WAIT_V(8); PG8_WAIT_L(0); PG8_BAR; PG8_MMA(1, 0, At, B0); PG8_MMA(1, 1, At, B1); PG8_BAR; PG8_SCHED;
            PG8_LDB(B0, 1, 0); PG8_LDB(B1, 1, 1); PG8_SCHED; PG8_LDA(At, 1, 0); PG8_STAGE(PG8_SA(0, 1), a2 + hstep, voffA);
            PG8_WAIT_V(8); PG8_WAIT_L(0); PG8_BAR; PG8_MMA(0, 0, At, B0); PG8_MMA(0, 1, At, B1); PG8_BAR; PG8_SCHED;
            PG8_LDA(At, 1, 1); PG8_STAGE(PG8_SB(1, 0), b3, voffB); PG8_STAGE(PG8_SB(1, 1), b3 + hstep, voffB); PG8_STAGE(PG8_SA(1, 0), a3, voffA);
            PG8_WAIT_V(8); PG8_WAIT_L(0); PG8_BAR; PG8_MMA(1, 0, At, B0); PG8_MMA(1, 1, At, B1); PG8_BAR; PG8_SCHED;
            } else {
            PG8_LDB(B0, 0, 0); PG8_SCHED; PG8_LDA(At, 0, 0); PG8_STAGE(PG8_SA(1, 1), a1 + hstep, voffA);
            PG8_WAIT_L(8); PG8_BAR; PG8_WAIT_L(0); PG8_MMA(0, 0, At, B0); PG8_BAR; PG8_SCHED;
            PG8_LDB(B1, 0, 1); PG8_STAGE(PG8_SB(0, 0), b2, voffB);
            PG8_BAR; PG8_WAIT_L(0); PG8_MMA(0, 1, At, B1); PG8_BAR;
            PG8_LDA(At, 0, 1); PG8_STAGE(PG8_SA(0, 0), a2, voffA);
            PG8_BAR; PG8_WAIT_L(0); PG8_MMA(1, 0, At, B0); PG8_BAR; PG8_SCHED;
            PG8_STAGE(PG8_SB(0, 1), b2 + hstep, voffB);
            PG8_WAIT_V(6); PG8_BAR; PG8_MMA(1, 1, At, B1); PG8_BAR;
            PG8_LDB(B0, 1, 0); PG8_SCHED; PG8_LDA(At, 1, 0); PG8_STAGE(PG8_SA(0, 1), a2 + hstep, voffA);
            PG8_WAIT_L(8); PG8_BAR; PG8_WAIT_L(0); PG8_MMA(0, 0, At, B0); PG8_BAR; PG8_SCHED;
            PG8_LDB(B1, 1, 1); PG8_STAGE(PG8_SB(1, 0), b3, voffB);
            PG8_BAR; PG8_WAIT_L(0); PG8_MMA(0, 1, At, B1); PG8_BAR;
            PG8_LDA(At, 1, 1); PG8_STAGE(PG8_SA(1, 0), a3, voffA);
            PG8_BAR; PG8_WAIT_L(0); PG8_MMA(1, 0, At, B0); PG8_BAR; PG8_SCHED;
            PG8_STAGE(PG8_SB(1, 1), b3 + hstep, voffB);
            PG8_WAIT_V(6); PG8_BAR; PG8_MMA(1, 1, At, B1); PG8_BAR;
            }
        }
        if constexpr (ALIGN_EPI) { if (wr == 0) PG8_BAR; }
        const bool keep = E(acc, cur, wr, wc, fr, fq);
        if (!has_next) break;
        if (!keep) {
#pragma unroll
        for (int a = 0; a < 2; ++a)
#pragma unroll
            for (int b = 0; b < 2; ++b)
#pragma unroll
                for (int m = 0; m < 4; ++m)
#pragma unroll
                    for (int n = 0; n < 2; ++n) acc[a][b][m][n] = (f32x4){0.f, 0.f, 0.f, 0.f};
        }
        cur = nxt; cA = nA; cB = nB; ++ui;
        if constexpr (ALIGN_EPI) { if (wr == 1) PG8_BAR; }
    }
    PG8_WAIT_V(0);
    if constexpr (!ALIGN_EPI) { if (wr == 0) PG8_BAR; }
    PG8_BAR;
#undef PG8_SA
#undef PG8_SB
#undef PG8_STAGE
#undef PG8_LDA
#undef PG8_LDB
#undef PG8_MMA
#undef PG8_WAIT_V
#undef PG8_WAIT_L
#undef PG8_BAR
#undef PG8_SCHED
}
}

constexpr int NWAVES = 8, NTHR = 512;
constexpr int D = 1024, NLAT = 32768, NCTX = 2048, NTOK = NLAT + NCTX, SEQ = 4096, CTXL = 256;
constexpr int INCOLS = 7200, NEXP = 16, DEXP = 1536, DEPTH = 2;
constexpr float EPS = 1e-6f;
constexpr int MPAD = 73728;
constexpr int MAXTILES = MPAD / 256;

constexpr size_t MiB = 1u << 20;
constexpr size_t WS_CTL = 0, CTL_ZERO_BYTES = 1 * MiB;
constexpr size_t WS_MOD = 1 * MiB;
constexpr size_t WS_LR = 2 * MiB;
constexpr size_t WS_EID = 7 * MiB;
constexpr size_t WS_WGT = 7 * MiB + 512 * 1024;
constexpr size_t WS_SPOS = 8 * MiB;
constexpr size_t WS_HISTG = 8 * MiB + 512 * 1024;
constexpr size_t WS_TILEE = 8 * MiB + 768 * 1024;
constexpr size_t WS_WLR = 9 * MiB;
constexpr size_t WS_CTXS = 10 * MiB;
constexpr size_t WS_W1T = 18 * MiB;
constexpr size_t WS_W2T = 34 * MiB;
constexpr size_t WS_WA = 46 * MiB;
constexpr size_t WS_WB = 50 * MiB;
constexpr size_t WS_WO = 54 * MiB;
constexpr size_t WS_WGU = 58 * MiB;
constexpr size_t WS_WD = 154 * MiB;
constexpr size_t WS_ACT = 202 * MiB;
constexpr size_t ROWB = 68 * MiB;
constexpr size_t WS_H = WS_ACT, WS_U = WS_ACT + ROWB, WS_V = WS_ACT + 2 * ROWB, WS_Q = WS_ACT + 3 * ROWB, WS_K = WS_Q + 34 * MiB,
                 WS_VV = WS_ACT + 4 * ROWB, WS_OF = WS_ACT + 5 * ROWB, WS_OB = WS_ACT + 6 * ROWB, WS_END = WS_ACT + 7 * ROWB;
constexpr size_t WS_R = WS_Q, WS_GR = WS_VV, WS_GB = WS_V, WS_MB = WS_OF;
constexpr size_t WS_H2 = WS_H, WS_XG = WS_ACT + ROWB, WS_HH = WS_XG + 144 * MiB;
static_assert(WS_HH + 216 * MiB <= WS_END, "moe overlay");
constexpr int CW_TMO = 0, CW_BAR = 4096;

constexpr int RING_BYTES = 131072;
constexpr int LDS_BYTES = 163840;
constexpr int MISC_OFF = LDS_BYTES - 256;

#define GAS __attribute__((address_space(1)))
#define LAS __attribute__((address_space(3)))
typedef unsigned short bf16;
typedef unsigned v4u __attribute__((ext_vector_type(4)));
typedef unsigned v2u __attribute__((ext_vector_type(2)));
typedef float f32x4 __attribute__((ext_vector_type(4)));
typedef float f32x2 __attribute__((ext_vector_type(2)));
#define LDS_WAIT() asm volatile("s_waitcnt lgkmcnt(0)" ::: "memory")
__device__ __forceinline__ int opaque_v(int v) { asm volatile("" : "+v"(v)); return v; }

__device__ __forceinline__ float bf_lo(unsigned u) { return __uint_as_float(u << 16); }
__device__ __forceinline__ float bf_hi(unsigned u) { return __uint_as_float(u & 0xffff0000u); }
__device__ __forceinline__ float bf1(bf16 b) { return __uint_as_float(((unsigned)b) << 16); }
__device__ __forceinline__ unsigned pk2(float lo, float hi) { return pg8::cvt_pk_bf16(lo, hi); }
__device__ __forceinline__ bf16 f2bf(float f) { return (bf16)(pg8::cvt_pk_bf16(f, 0.f) & 0xffffu); }
__device__ __forceinline__ float wave_sum(float v) {
#pragma unroll
    for (int o = 1; o < 64; o <<= 1) v += __shfl_xor(v, o);
    return v;
}
__device__ __forceinline__ float fsigmoid(float x) { return __builtin_amdgcn_rcpf(1.0f + __expf(-x)); }
__device__ __forceinline__ float fsilu(float x) { return x * fsigmoid(x); }
__device__ __forceinline__ float fgelu_tanh(float x) { const float u = 0.7978845608028654f * (x + 0.044715f * x * x * x); return x * fsigmoid(2.0f * u); }

#define XB_TMO      128
#define XB_XCNT(j)  (256  + 64 * (j))
#define XB_XSUB(j)  (1280 + 64 * (j))
#define XB_XGEN(j)  (2304 + 64 * (j))
#define XB_TOP      3328
#define XB_TOPGEN   3392
#define XCD_BAR_WORDS 3456
#define XB_SPIN_CAP (1u << 18)
__device__ __forceinline__ unsigned xb_ld(unsigned* p)              { return __hip_atomic_load(p, __ATOMIC_RELAXED, __HIP_MEMORY_SCOPE_AGENT); }
__device__ __forceinline__ unsigned xb_add(unsigned* p, unsigned v) { return __hip_atomic_fetch_add(p, v, __ATOMIC_RELAXED, __HIP_MEMORY_SCOPE_AGENT); }
__device__ __forceinline__ unsigned xb_xcc_id() { return (unsigned)__builtin_amdgcn_s_getreg((3 << 11) | 20) & 0xFu; }
#define XB_SPIN(cond, bar) do { unsigned _sp = 0; while (cond) { __builtin_amdgcn_s_sleep(1); \
    if ((++_sp & 255u) == 0u) { if (xb_ld(&(bar)[XB_TMO])) break; if (_sp > XB_SPIN_CAP) { atomicAdd(&(bar)[XB_TMO], 1u); break; } } } } while (0)
struct XcdBarrier { unsigned* bar; unsigned x; volatile LAS unsigned* st; };
__device__ __forceinline__ XcdBarrier xcd_barrier_post(unsigned* bar, volatile LAS unsigned* st) {
    XcdBarrier b; b.bar = bar; b.x = xb_xcc_id(); b.st = st;
    if (threadIdx.x == 0) (void)xb_add(&bar[XB_XCNT(b.x)], 1u);
    return b;
}
__device__ __forceinline__ void xcd_barrier_complete(unsigned* bar, unsigned x, unsigned& nloc, unsigned& nx) {
    const unsigned G = gridDim.x * gridDim.y * gridDim.z;
    unsigned sum, cnt, mine, sp = 0u;
    for (;;) {
        sum = 0u; cnt = 0u; mine = 0u;
#pragma unroll
        for (unsigned j = 0; j < 16; ++j) { const unsigned c = xb_ld(&bar[XB_XCNT(j)]); sum += c; cnt += (c > 0u) ? 1u : 0u; mine = (j == x) ? c : mine; }
        if (sum == G) break;
        __builtin_amdgcn_s_sleep(1);
        if ((++sp & 255u) == 0u) { if (xb_ld(&bar[XB_TMO])) break; if (sp > XB_SPIN_CAP) { atomicAdd(&bar[XB_TMO], 1u); break; } }
    }
    nloc = mine > 0u ? mine : 1u; nx = cnt > 0u ? cnt : 1u;
}
__device__ __forceinline__ void xcd_barrier(const XcdBarrier& b) {
    asm volatile("s_waitcnt vmcnt(0)" ::: "memory");
    __syncthreads();
    if (threadIdx.x == 0) {
        unsigned* bar = b.bar;
        __builtin_amdgcn_s_waitcnt(0);
        unsigned nloc = b.st[0], nx = b.st[1];
        if (nloc == 0u) { xcd_barrier_complete(bar, b.x, nloc, nx); b.st[0] = nloc; b.st[1] = nx; }
        const unsigned old = xb_add(&bar[XB_XSUB(b.x)], 1u);
        const unsigned gen = old / nloc;
        if (old + 1u == (gen + 1u) * nloc) {
            __builtin_amdgcn_fence(__ATOMIC_RELEASE, "agent");
            asm volatile("s_waitcnt vmcnt(0)" ::: "memory");
            const unsigned og = xb_add(&bar[XB_TOP], 1u);
            const unsigned tg = og / nx;
            if (og + 1u == (tg + 1u) * nx) xb_add(&bar[XB_TOPGEN], 1u);
            else XB_SPIN(xb_ld(&bar[XB_TOPGEN]) == tg, bar);
            __builtin_amdgcn_fence(__ATOMIC_ACQUIRE, "agent");
            xb_add(&bar[XB_XGEN(b.x)], 1u);
            asm volatile("s_waitcnt vmcnt(0)" ::: "memory");
        } else {
            XB_SPIN(xb_ld(&bar[XB_XGEN(b.x)]) == gen, bar);
            __builtin_amdgcn_fence(__ATOMIC_ACQUIRE, "agent");
            asm volatile("s_waitcnt vmcnt(0)" ::: "memory");
        }
    }
    __syncthreads();
}

struct Ctx {
    LAS unsigned char* lds;
    unsigned char* ws;
    int tid, lane, wave, G, blk;
    const float *x, *c, *ctx, *c_ctx, *w_mod, *b_mod, *g1, *g2, *w_in, *w_gate2, *b_gate2, *gla_g, *ln_g, *ln_b, *sgu_w, *sgu_b,
                *w_a, *w_b, *b_branch, *w_out, *w_router, *b_router, *w_eg, *w_eu, *w_ed, *g_final;
    float* out;
};
#define WSP(T, off) ((T*)(F.ws + (off)))

template <int ACT  >
__device__ __forceinline__ void store_tile_bf16(const pg8::f32x4 (&acc)[2][2][4][2], bf16* dst, int ld, int row0, int col0, float scale) {
#pragma unroll
    for (int ai = 0; ai < 2; ++ai)
#pragma unroll
        for (int m = 0; m < 4; ++m) { bf16* rowp = dst + (size_t)(row0 + ai * 128 + m * 16) * ld + col0;
#pragma unroll
            for (int bj = 0; bj < 2; ++bj) { pg8::f32x4 v0 = acc[ai][bj][m][0], v1 = acc[ai][bj][m][1];
                if (ACT == 1) {
#pragma unroll
                    for (int j = 0; j < 4; ++j) { v0[j] = fgelu_tanh(v0[j]); v1[j] = fgelu_tanh(v1[j]); } }
                if (ACT == 2) {
#pragma unroll
                    for (int j = 0; j < 4; ++j) { v0[j] = fsilu(v0[j]); v1[j] = fsilu(v1[j]); } }
                if (ACT == 3) { v0 = v0 * scale; v1 = v1 * scale; }
                v4u w; w.x = pk2(v0[0], v0[1]); w.y = pk2(v0[2], v0[3]); w.z = pk2(v1[0], v1[1]); w.w = pk2(v1[2], v1[3]);
                *(v4u*)(rowp + bj * 128) = w; } }
}
struct EpiI1 {
    static constexpr bool PERM = true;
    bf16 *U, *V, *Q, *K, *VV;
    __device__ __forceinline__ bool operator()(pg8::f32x4 (&acc)[2][2][4][2], const pg8::Unit& u, int wr, int wc, int fr, int fq) const {
        const int row0 = u.pm * 256 + wr * 64 + fr, cl = wc * 32 + 8 * fq;
        if (u.pn < 4)       store_tile_bf16<1>(acc, U, 1024, row0, u.pn * 256 + cl, 1.f);
        else if (u.pn < 8)  store_tile_bf16<1>(acc, V, 1024, row0, (u.pn - 4) * 256 + cl, 1.f);
        else if (u.pn < 10) store_tile_bf16<3>(acc, Q, 512, row0, (u.pn - 8) * 256 + cl, 0.08838834764831845f);
        else if (u.pn < 12) store_tile_bf16<0>(acc, K, 512, row0, (u.pn - 10) * 256 + cl, 1.f);
        else                store_tile_bf16<0>(acc, VV, 1024, row0, (u.pn - 12) * 256 + cl, 1.f);
        return false;
    }
};
struct EpiI2 {
    static constexpr bool PERM = true;
    bf16 *R, *GR, *GB; const float* bb;
    __device__ __forceinline__ bool operator()(pg8::f32x4 (&acc)[2][2][4][2], const pg8::Unit& u, int wr, int wc, int fr, int fq) const {
        const int row0 = u.pm * 256 + wr * 64 + fr, cl = wc * 32 + 8 * fq;
        if (u.pn < 4) { store_tile_bf16<2>(acc, R, 1024, row0, u.pn * 256 + cl, 1.f); return false; }
        const int col0 = (u.pn - 4) * 128 + cl;
        pg8::f32x4 ba[2], bbv[2];
#pragma unroll
        for (int n = 0; n < 2; ++n) { ba[n] = *(const pg8::f32x4*)(bb + col0 + 4 * n); bbv[n] = *(const pg8::f32x4*)(bb + 1024 + col0 + 4 * n); }
#pragma unroll
        for (int ai = 0; ai < 2; ++ai)
#pragma unroll
            for (int m = 0; m < 4; ++m) { const size_t off = (size_t)(row0 + ai * 128 + m * 16) * 1024 + col0;
                float ra[8], sb[8];
#pragma unroll
                for (int n = 0; n < 2; ++n)
#pragma unroll
                    for (int j = 0; j < 4; ++j) { float xa = acc[ai][0][m][n][j] + ba[n][j], xb = acc[ai][1][m][n][j] + bbv[n][j];
                        xa = fminf(fmaxf(xa, -30.f), 30.f); xb = fminf(fmaxf(xb, -30.f), 30.f);
                        const float ea = 1.0f + __expf(-xa), eb = 1.0f + __expf(-xb);
                        ra[n * 4 + j] = eb * __builtin_amdgcn_rcpf(ea); sb[n * 4 + j] = __builtin_amdgcn_rcpf(eb); }
                v4u w; w.x = pk2(ra[0], ra[1]); w.y = pk2(ra[2], ra[3]); w.z = pk2(ra[4], ra[5]); w.w = pk2(ra[6], ra[7]);
                *(v4u*)(GR + off) = w;
                v4u w2; w2.x = pk2(sb[0], sb[1]); w2.y = pk2(sb[2], sb[3]); w2.z = pk2(sb[4], sb[5]); w2.w = pk2(sb[6], sb[7]);
                *(v4u*)(GB + off) = w2; }
        return false;
    }
};
struct EpiM1 {
    static constexpr bool PERM = true;
    const bf16 *GR, *GB; bf16* MB;
    __device__ __forceinline__ bool operator()(pg8::f32x4 (&acc)[2][2][4][2], const pg8::Unit& u, int wr, int wc, int fr, int fq) const {
        const int row0 = u.pm * 256 + wr * 64 + fr, col0 = u.pn * 256 + wc * 32 + 8 * fq;
        const bf16* Gs = u.sub ? GB : GR;
#pragma unroll
        for (int ai = 0; ai < 2; ++ai)
#pragma unroll
            for (int m = 0; m < 4; ++m) { const size_t off = (size_t)(row0 + ai * 128 + m * 16) * 1024 + col0;
#pragma unroll
                for (int bj = 0; bj < 2; ++bj) { const v4u g = *(const v4u*)(Gs + off + bj * 128);
                    pg8::f32x4 v0 = acc[ai][bj][m][0], v1 = acc[ai][bj][m][1];
                    v0[0] *= bf_lo(g.x); v0[1] *= bf_hi(g.x); v0[2] *= bf_lo(g.y); v0[3] *= bf_hi(g.y);
                    v1[0] *= bf_lo(g.z); v1[1] *= bf_hi(g.z); v1[2] *= bf_lo(g.w); v1[3] *= bf_hi(g.w);
                    if (u.sub) { v4u w; w.x = pk2(v0[0], v0[1]); w.y = pk2(v0[2], v0[3]); w.z = pk2(v1[0], v1[1]); w.w = pk2(v1[2], v1[3]); *(v4u*)(MB + off + bj * 128) = w; }
                    else { acc[ai][bj][m][0] = v0; acc[ai][bj][m][1] = v1; } } }
        return u.sub == 0;
    }
};
struct EpiM2 {
    static constexpr bool PERM = false;
    const float* xlat; const float* xctx; float* olat; float* octx; const float* mod;
    __device__ __forceinline__ bool operator()(pg8::f32x4 (&acc)[2][2][4][2], const pg8::Unit& u, int wr, int wc, int fr, int fq) const {
        const bool isctx = u.pm >= 128; const int pml = isctx ? u.pm - 128 : u.pm; const int mb = isctx ? 8 : (u.pm >> 4);
        const float* src = isctx ? xctx : xlat; float* dst = isctx ? octx : olat;
        const int row0 = pml * 256 + wr * 64 + fr, col0 = u.pn * 256 + wc * 32 + 4 * fq;
        const float* gt = mod + mb * 6144 + 2 * 1024;
        pg8::f32x4 gv[2][2];
#pragma unroll
        for (int bj = 0; bj < 2; ++bj)
#pragma unroll
            for (int n = 0; n < 2; ++n) gv[bj][n] = *(const pg8::f32x4*)(gt + col0 + bj * 128 + n * 16);
#pragma unroll
        for (int ai = 0; ai < 2; ++ai)
#pragma unroll
            for (int m = 0; m < 4; ++m) { const size_t off = (size_t)(row0 + ai * 128 + m * 16) * 1024 + col0;
#pragma unroll
                for (int bj = 0; bj < 2; ++bj)
#pragma unroll
                    for (int n = 0; n < 2; ++n) { const pg8::f32x4 xv = *(const pg8::f32x4*)(src + off + bj * 128 + n * 16);
                        *(pg8::f32x4*)(dst + off + bj * 128 + n * 16) = xv + gv[bj][n] * acc[ai][bj][m][n]; } }
        return false;
    }
};
struct EpiG1 {
    static constexpr bool PERM = true;
    bf16* HH;
    __device__ __forceinline__ bool operator()(pg8::f32x4 (&acc)[2][2][4][2], const pg8::Unit& u, int wr, int wc, int fr, int fq) const {
        const int row0 = u.pm * 256 + wr * 64 + fr, col0 = u.pn * 128 + wc * 32 + 8 * fq;
#pragma unroll
        for (int ai = 0; ai < 2; ++ai)
#pragma unroll
            for (int m = 0; m < 4; ++m) { float h[8];
#pragma unroll
                for (int n = 0; n < 2; ++n)
#pragma unroll
                    for (int j = 0; j < 4; ++j) h[n * 4 + j] = fsilu(acc[ai][0][m][n][j]) * acc[ai][1][m][n][j];
                v4u w; w.x = pk2(h[0], h[1]); w.y = pk2(h[2], h[3]); w.z = pk2(h[4], h[5]); w.w = pk2(h[6], h[7]);
                *(v4u*)(HH + (size_t)(row0 + ai * 128 + m * 16) * DEXP + col0) = w; }
        return false;
    }
};
struct EpiG2 {
    static constexpr bool PERM = true;
    bf16* Y;
    __device__ __forceinline__ bool operator()(pg8::f32x4 (&acc)[2][2][4][2], const pg8::Unit& u, int wr, int wc, int fr, int fq) const {
        store_tile_bf16<0>(acc, Y, 1024, u.pm * 256 + wr * 64 + fr, u.pn * 256 + wc * 32 + 8 * fq, 1.f);
        return false;
    }
};

__device__ __forceinline__ void tr_item(const float* src, int ld_src, int k0, int n0, bf16* dst, int ld_dst, int r0, LAS float* scr, int lane) {
#pragma unroll 8
    for (int i = 0; i < 32; ++i) { const int kk = 2 * i + (lane >> 5); scr[kk * 33 + (lane & 31)] = src[(size_t)(k0 + kk) * ld_src + n0 + (lane & 31)]; }
    LDS_WAIT(); asm volatile("" ::: "memory");
    const int c = lane & 7;
#pragma unroll
    for (int j = 0; j < 4; ++j) { const int n = (lane >> 3) + 8 * j; const LAS float* s = scr + (8 * c) * 33 + n;
        v4u o; o.x = pk2(s[0 * 33], s[1 * 33]); o.y = pk2(s[2 * 33], s[3 * 33]); o.z = pk2(s[4 * 33], s[5 * 33]); o.w = pk2(s[6 * 33], s[7 * 33]);
        *(v4u*)(dst + (size_t)(r0 + n) * ld_dst + k0 + 8 * c) = o; }
    LDS_WAIT(); asm volatile("" ::: "memory");
}
__device__ __forceinline__ void convert_experts(Ctx& F, int layer, int gw, int NGW) {
    LAS float* scr = (LAS float*)(F.lds + F.wave * 16384);
    bf16* WGU = WSP(bf16, WS_WGU); bf16* WD = WSP(bf16, WS_WD);
    constexpr int I_GU = 16 * 48, I_D = 24 * 32, PER_E = 2 * I_GU + I_D;
    for (int it = gw; it < NEXP * PER_E; it += NGW) {
        const int e = it / PER_E; int r = it % PER_E;
        if (r < 2 * I_GU) { const int up = r >= I_GU; if (up) r -= I_GU; const int kb = r / 48, nb = r % 48, n0 = nb * 32;
            const size_t so = ((size_t)layer * NEXP + e) * D * DEXP;
            if (up) tr_item(F.w_eu + so, DEXP, kb * 64, n0, WGU + (size_t)e * 3072 * 1024, 1024, (n0 >> 7) * 256 + 128 + (n0 & 127), scr, F.lane);
            else    tr_item(F.w_eg + so, DEXP, kb * 64, n0, WGU + (size_t)e * 3072 * 1024, 1024, (n0 >> 7) * 256 + (n0 & 127), scr, F.lane); }
        else { r -= 2 * I_GU; const int kb = r / 32, nb = r % 32;
            tr_item(F.w_ed + ((size_t)layer * NEXP + e) * DEXP * D, D, kb * 64, nb * 32, WD + (size_t)e * 1024 * DEXP, DEXP, nb * 32, scr, F.lane); }
    }
}
__device__ __forceinline__ void p0_prologue(Ctx& F) {
    if (F.blk < 192) {
        LAS float* SC = (LAS float*)F.lds;
        LAS float* PART = (LAS float*)(F.lds + 40960);
        for (int i = F.tid; i < 9 * 1024; i += NTHR) { const float v = i < 8192 ? F.c[i] : F.c_ctx[i - 8192]; SC[i] = fsilu(v); }
        __syncthreads();
        const int l = F.blk / 96, jg = F.blk % 96, j = jg * 64 + F.lane;
        const float* W = F.w_mod + (size_t)l * D * 6144 + j;
        float acc[9];
#pragma unroll
        for (int r = 0; r < 9; ++r) acc[r] = 0.f;
        const int k0 = F.wave * 128;
#pragma unroll 8
        for (int k = k0; k < k0 + 128; ++k) { const float w = W[(size_t)k * 6144];
#pragma unroll
            for (int r = 0; r < 9; ++r) acc[r] += SC[r * 1024 + k] * w; }
#pragma unroll
        for (int r = 0; r < 9; ++r) PART[(F.wave * 9 + r) * 64 + F.lane] = acc[r];
        __syncthreads();
        float* MOD = WSP(float, WS_MOD);
        for (int idx = F.tid; idx < 576; idx += NTHR) { const int r = idx >> 6, cc = idx & 63; float s = F.b_mod[l * 6144 + jg * 64 + cc];
#pragma unroll
            for (int w = 0; w < 8; ++w) s += PART[(w * 9 + r) * 64 + cc];
            MOD[(size_t)(l * 9 + r) * 6144 + jg * 64 + cc] = s; }
        __syncthreads();
    }
    const int gw = F.blk * NWAVES + F.wave, NGW = F.G * NWAVES;
    LAS float* scr = (LAS float*)(F.lds + F.wave * 16384);
    {
        constexpr int PER_L = 2048 + 512 + 1024 + 3 * 512;
        for (int it = gw; it < 2 * PER_L; it += NGW) {
            const int l = it / PER_L; int r = it % PER_L;
            const float* win = F.w_in + (size_t)l * D * INCOLS;
            if (r < 2048) { const int kb = r / 128, nb = r % 128; tr_item(win, INCOLS, kb * 64, nb * 32, WSP(bf16, WS_W1T) + (size_t)l * 4096 * 1024, 1024, nb * 32, scr, F.lane); continue; } r -= 2048;
            if (r < 512) { const int kb = r / 32, nb = r % 32; tr_item(win, INCOLS, kb * 64, 4096 + nb * 32, WSP(bf16, WS_W2T) + (size_t)l * 3072 * 1024, 1024, nb * 32, scr, F.lane); continue; } r -= 512;
            if (r < 1024) { const int kb = r / 64, nb = r % 64; const int j0 = nb * 32; const int isb = j0 >= 1024; const int j = isb ? j0 - 1024 : j0;
                tr_item(win, INCOLS, kb * 64, 5152 + j0, WSP(bf16, WS_W2T) + (size_t)l * 3072 * 1024, 1024, 1024 + (j >> 7) * 256 + (isb ? 128 : 0) + (j & 127), scr, F.lane); continue; } r -= 1024;
            const int which = r / 512; r %= 512; const int kb = r / 32, nb = r % 32;
            const size_t lo_ = (size_t)l * D * D;
            if (which == 0)      tr_item(F.w_a + lo_, D, kb * 64, nb * 32, WSP(bf16, WS_WA) + lo_, D, nb * 32, scr, F.lane);
            else if (which == 1) tr_item(F.w_b + lo_, D, kb * 64, nb * 32, WSP(bf16, WS_WB) + lo_, D, nb * 32, scr, F.lane);
            else                 tr_item(F.w_out + lo_, D, kb * 64, nb * 32, WSP(bf16, WS_WO) + lo_, D, nb * 32, scr, F.lane);
        }
        unsigned* WLR = WSP(unsigned, WS_WLR);
        for (int i = F.blk * NTHR + F.tid; i < 2 * 512 * 32; i += F.G * NTHR) { const int l = i >> 14, kp = (i >> 5) & 511, cc = i & 31;
            const float* win = F.w_in + (size_t)l * D * INCOLS + 5120 + cc;
            WLR[i] = pk2(win[(size_t)(2 * kp) * INCOLS], win[(size_t)(2 * kp + 1) * INCOLS]); }
    }
    convert_experts(F, 0, gw, NGW);
}

template <int MODE>
__device__ __forceinline__ void phase_rows(Ctx& F, int lc  , int ln  ) {
    LAS unsigned* WL = (LAS unsigned*)F.lds;
    LAS unsigned* HS = (LAS unsigned*)(F.lds + 65536);
    const int nrows = (MODE == 2) ? NLAT : NTOK;
    if (MODE <= 1) { const unsigned* WLR = WSP(unsigned, WS_WLR) + ln * 16384; for (int i = F.tid; i < 16384; i += NTHR) WL[i] = WLR[i]; }
    __syncthreads();
    const float* MODn = WSP(float, WS_MOD) + (size_t)ln * 9 * 6144;
    const float* MODc = WSP(float, WS_MOD) + (size_t)lc * 9 * 6144;
    bf16* H = WSP(bf16, WS_H); const bf16* Y = WSP(bf16, WS_XG); float* LR = WSP(float, WS_LR); float* CTXS = WSP(float, WS_CTXS);
    const int* SPOS = WSP(int, WS_SPOS); const float* WGT = WSP(float, WS_WGT);
    const int ngroups = nrows / 16;
    for (int gi = F.blk; gi < ngroups; gi += F.G) {
#pragma unroll 1
        for (int rr = 0; rr < 2; ++rr) {
            const int rl = F.wave * 2 + rr, m = gi * 16 + rl;
            const int mb = m < NLAT ? (m >> 12) : 8;
            f32x4 v[4];
            if (MODE == 0) { const float* xr = (m < NLAT) ? F.x + (size_t)m * D : F.ctx + (size_t)(m - NLAT) * D;
#pragma unroll
                for (int j = 0; j < 4; ++j) v[j] = *(const f32x4*)(xr + 4 * F.lane + 256 * j); }
            else { float* xr = (m < NLAT) ? F.out + (size_t)m * D : CTXS + (size_t)(m - NLAT) * D;
                const int p0 = SPOS[2 * m], p1 = SPOS[2 * m + 1]; const float w0 = WGT[2 * m], w1 = WGT[2 * m + 1];
                const float* gt2 = MODc + mb * 6144 + 5 * 1024;
#pragma unroll
                for (int j = 0; j < 4; ++j) { const int k = 4 * F.lane + 256 * j;
                    const f32x4 xv = *(const f32x4*)(xr + k); const f32x4 g = *(const f32x4*)(gt2 + k);
                    const v2u a = *(const v2u*)(Y + (size_t)p0 * D + k), b = *(const v2u*)(Y + (size_t)p1 * D + k);
                    f32x4 y; y[0] = w0 * bf_lo(a.x) + w1 * bf_lo(b.x); y[1] = w0 * bf_hi(a.x) + w1 * bf_hi(b.x); y[2] = w0 * bf_lo(a.y) + w1 * bf_lo(b.y); y[3] = w0 * bf_hi(a.y) + w1 * bf_hi(b.y);
                    v[j] = xv + g * y;
                    if (MODE == 1) *(f32x4*)(xr + k) = v[j]; } }
            float ss = 0.f;
#pragma unroll
            for (int j = 0; j < 4; ++j) ss += (v[j][0] * v[j][0] + v[j][1] * v[j][1]) + (v[j][2] * v[j][2] + v[j][3] * v[j][3]);
            const float rstd = rsqrtf(wave_sum(ss) * (1.0f / D) + EPS);
            if (MODE == 2) {
#pragma unroll
                for (int j = 0; j < 4; ++j) { const int k = 4 * F.lane + 256 * j; const f32x4 g = *(const f32x4*)(F.g_final + k);
                    *(f32x4*)(F.out + (size_t)m * D + k) = v[j] * rstd * g; } }
            else {
                const float* g1 = F.g1 + ln * D; const float* sh = MODn + mb * 6144; const float* sc = sh + 1024;
#pragma unroll
                for (int j = 0; j < 4; ++j) { const int k = 4 * F.lane + 256 * j;
                    const f32x4 g = *(const f32x4*)(g1 + k), s1 = *(const f32x4*)(sc + k), s0 = *(const f32x4*)(sh + k);
                    const f32x4 hv = v[j] * rstd * g * (s1 + 1.0f) + s0;
                    v2u o; o.x = pk2(hv[0], hv[1]); o.y = pk2(hv[2], hv[3]);
                    *(v2u*)(H + (size_t)m * D + k) = o;
                    *(LAS v2u*)(HS + rl * 512 + (k >> 1)) = o; } }
        }
        if (MODE <= 1) {
            __syncthreads();
            const int r = F.tid >> 5, cc = F.tid & 31; float acc = 0.f;
#pragma unroll 8
            for (int kp = 0; kp < 512; ++kp) { const unsigned hv = HS[r * 512 + kp], wv = WL[kp * 32 + cc]; acc += bf_lo(hv) * bf_lo(wv) + bf_hi(hv) * bf_hi(wv); }
            LR[(size_t)(gi * 16 + r) * 32 + cc] = acc;
            __syncthreads();
        }
    }
}

__device__ __forceinline__ void phase_gla(Ctx& F, int l) {
    LAS float* BX = (LAS float*)F.lds;
    LAS float* ATT = BX; LAS float* VS = BX + 4096;
    LAS float* QI = (LAS float*)(F.lds + 32768);
    LAS float* KI = (LAS float*)(F.lds + 65536);
    LAS float* SS = (LAS float*)(F.lds + 99328);
    LAS float* LRS = (LAS float*)(F.lds + 140288);
    LAS float* B2S = (LAS float*)(F.lds + 144384);
    LAS float* BLAST = (LAS float*)(F.lds + 144896);
    LAS float* EBL = (LAS float*)(F.lds + 145408);
    const bf16* Qb = WSP(bf16, WS_Q); const bf16* Kb = WSP(bf16, WS_K); const bf16* Vb = WSP(bf16, WS_VV); const float* LR = WSP(float, WS_LR);
    const int tid = F.tid, lane = F.lane, w = F.wave;
    for (int u = F.blk; u < 256; u += F.G) {
        const int sl = u & 3, dir = (u >> 2) & 1, hd = (u >> 3) & 3, b = u >> 5;
        bf16* O = WSP(bf16, dir ? WS_OB : WS_OF);
        __syncthreads();
        const int kk1 = tid & 127, i01 = tid >> 7;
        float w2[16];
#pragma unroll
        for (int r = 0; r < 16; ++r) w2[r] = F.w_gate2[((size_t)(l * 2 + dir) * 16 + r) * 512 + hd * 128 + kk1];
        if (tid < 128) B2S[tid] = F.b_gate2[(l * 2 + dir) * 512 + hd * 128 + tid];
        for (int i = tid; i < 8192; i += NTHR) SS[i] = 0.f;
        v4u qreg[2], kreg[2], vreg; f32x2 lrreg;
#define GLA_TOK(base, i) ((base) + (dir ? 63 - (i) : (i)))
#define GLA_BASE(s) ((s) < 4 ? NLAT + b * CTXL + (dir ? 3 - (s) : (s)) * 64 : b * SEQ + (dir ? 63 - ((s) - 4) : ((s) - 4)) * 64)
#define GLA_LOAD(s) do { const int base_ = GLA_BASE(s); \
        _Pragma("unroll") for (int jj = 0; jj < 2; ++jj) { const int p = tid + 512 * jj, i = p >> 4, c8 = (p & 15) * 8; const size_t t_ = (size_t)GLA_TOK(base_, i); \
            qreg[jj] = *(const v4u*)(Qb + t_ * 512 + hd * 128 + c8); kreg[jj] = *(const v4u*)(Kb + t_ * 512 + hd * 128 + c8); } \
        { const int i = tid >> 3, c8 = (tid & 7) * 8; vreg = *(const v4u*)(Vb + (size_t)GLA_TOK(base_, i) * 1024 + hd * 256 + sl * 64 + c8); } \
        { const int idx = tid * 2, i = idx >> 4, r = idx & 15; lrreg = *(const f32x2*)(LR + (size_t)GLA_TOK(base_, i) * 32 + dir * 16 + r); } } while (0)
        GLA_LOAD(0);
#pragma unroll 1
        for (int s = 0; s < 68; ++s) {
            const int base = GLA_BASE(s);
            { const int idx = tid * 2; LRS[idx] = lrreg[0]; LRS[idx + 1] = lrreg[1]; }
            __syncthreads();
            { const float bz = B2S[kk1];
#pragma unroll 4
              for (int j = 0; j < 16; ++j) { const int i = i01 + 4 * j; float z = bz;
#pragma unroll
                  for (int r4 = 0; r4 < 4; ++r4) { const f32x4 lv = *(const LAS f32x4*)(LRS + i * 16 + r4 * 4); z += lv[0] * w2[r4 * 4] + lv[1] * w2[r4 * 4 + 1] + lv[2] * w2[r4 * 4 + 2] + lv[3] * w2[r4 * 4 + 3]; }
                  const float la = (fminf(z, 0.f) - __logf(1.0f + __expf(-fabsf(z)))) * 0.0625f;
                  BX[i * 128 + kk1] = la; } }
            __syncthreads();
            if (tid < 128) { float run = 0.f;
#pragma unroll 8
                for (int i = 0; i < 64; ++i) { run += BX[i * 128 + tid]; BX[i * 128 + tid] = run; }
                BLAST[tid] = run; EBL[tid] = __expf(run); }
            __syncthreads();
#pragma unroll
            for (int jj = 0; jj < 2; ++jj) { const int p = tid + 512 * jj, i = p >> 4, c8 = (p & 15) * 8;
                const f32x4 b0 = *(const LAS f32x4*)(BX + i * 128 + c8), b1 = *(const LAS f32x4*)(BX + i * 128 + c8 + 4);
                const v4u q = qreg[jj], k = kreg[jj];
                f32x4 q0, q1, k0, k1;
                q0[0] = bf_lo(q.x) * __expf(b0[0]); q0[1] = bf_hi(q.x) * __expf(b0[1]); q0[2] = bf_lo(q.y) * __expf(b0[2]); q0[3] = bf_hi(q.y) * __expf(b0[3]);
                q1[0] = bf_lo(q.z) * __expf(b1[0]); q1[1] = bf_hi(q.z) * __expf(b1[1]); q1[2] = bf_lo(q.w) * __expf(b1[2]); q1[3] = bf_hi(q.w) * __expf(b1[3]);
                k0[0] = bf_lo(k.x) * __expf(-b0[0]); k0[1] = bf_hi(k.x) * __expf(-b0[1]); k0[2] = bf_lo(k.y) * __expf(-b0[2]); k0[3] = bf_hi(k.y) * __expf(-b0[3]);
                k1[0] = bf_lo(k.z) * __expf(-b1[0]); k1[1] = bf_hi(k.z) * __expf(-b1[1]); k1[2] = bf_lo(k.w) * __expf(-b1[2]); k1[3] = bf_hi(k.w) * __expf(-b1[3]);
                *(LAS f32x4*)(QI + i * 128 + c8) = q0; *(LAS f32x4*)(QI + i * 128 + c8 + 4) = q1;
                *(LAS f32x4*)(KI + i * 132 + c8) = k0; *(LAS f32x4*)(KI + i * 132 + c8 + 4) = k1; }
            __syncthreads();
            { const int i = tid >> 3, c8 = (tid & 7) * 8; f32x4 v0, v1;
              v0[0] = bf_lo(vreg.x); v0[1] = bf_hi(vreg.x); v0[2] = bf_lo(vreg.y); v0[3] = bf_hi(vreg.y);
              v1[0] = bf_lo(vreg.z); v1[1] = bf_hi(vreg.z); v1[2] = bf_lo(vreg.w); v1[3] = bf_hi(vreg.w);
              *(LAS f32x4*)(VS + i * 64 + c8) = v0; *(LAS f32x4*)(VS + i * 64 + c8 + 4) = v1; }
            if (s + 1 < 68) GLA_LOAD(s + 1);
            { float a8[8];
#pragma unroll
              for (int e = 0; e < 8; ++e) a8[e] = 0.f;
#pragma unroll 4
              for (int k4 = 0; k4 < 32; ++k4) { const f32x4 kv = *(const LAS f32x4*)(KI + lane * 132 + k4 * 4);
#pragma unroll
                  for (int e = 0; e < 8; ++e) { const f32x4 qv = *(const LAS f32x4*)(QI + (w * 8 + e) * 128 + k4 * 4); a8[e] += (qv[0] * kv[0] + qv[1] * kv[1]) + (qv[2] * kv[2] + qv[3] * kv[3]); } }
#pragma unroll
              for (int e = 0; e < 8; ++e) ATT[(w * 8 + e) * 64 + lane] = (lane <= w * 8 + e) ? a8[e] : 0.f; }
            __syncthreads();
            { float o8[8];
#pragma unroll
              for (int e = 0; e < 8; ++e) o8[e] = 0.f;
#pragma unroll 2
              for (int s4 = 0; s4 < 16; ++s4) { const float v0 = VS[(s4 * 4) * 64 + lane], v1 = VS[(s4 * 4 + 1) * 64 + lane], v2 = VS[(s4 * 4 + 2) * 64 + lane], v3 = VS[(s4 * 4 + 3) * 64 + lane];
#pragma unroll
                  for (int e = 0; e < 8; ++e) { const f32x4 a = *(const LAS f32x4*)(ATT + (w * 8 + e) * 64 + s4 * 4); o8[e] += (a[0] * v0 + a[1] * v1) + (a[2] * v2 + a[3] * v3); } }
#pragma unroll 2
              for (int k4 = 0; k4 < 32; ++k4) { const float s0 = SS[(k4 * 4) * 64 + lane], s1 = SS[(k4 * 4 + 1) * 64 + lane], s2 = SS[(k4 * 4 + 2) * 64 + lane], s3 = SS[(k4 * 4 + 3) * 64 + lane];
#pragma unroll
                  for (int e = 0; e < 8; ++e) { const f32x4 qv = *(const LAS f32x4*)(QI + (w * 8 + e) * 128 + k4 * 4); o8[e] += (qv[0] * s0 + qv[1] * s1) + (qv[2] * s2 + qv[3] * s3); } }
#pragma unroll
              for (int e = 0; e < 8; ++e) { const int i = w * 8 + e; O[(size_t)GLA_TOK(base, i) * 1024 + hd * 256 + sl * 64 + lane] = f2bf(o8[e]); } }
            __syncthreads();
            { float a16[16];
#pragma unroll
              for (int e = 0; e < 16; ++e) a16[e] = 0.f;
#pragma unroll 2
              for (int t = 0; t < 64; ++t) { const float v = VS[t * 64 + lane];
#pragma unroll
                  for (int q4 = 0; q4 < 4; ++q4) { const f32x4 kv = *(const LAS f32x4*)(KI + t * 132 + w * 16 + q4 * 4);
                      a16[q4 * 4] += kv[0] * v; a16[q4 * 4 + 1] += kv[1] * v; a16[q4 * 4 + 2] += kv[2] * v; a16[q4 * 4 + 3] += kv[3] * v; } }
#pragma unroll
              for (int e = 0; e < 16; ++e) { const int kk = w * 16 + e; SS[kk * 64 + lane] = EBL[kk] * (SS[kk * 64 + lane] + a16[e]); } }
            __syncthreads();
        }
#undef GLA_LOAD
#undef GLA_BASE
#undef GLA_TOK
    }
}

__device__ __forceinline__ void phase_sgu(Ctx& F, int l, int nrows) {
    LAS float* T = (LAS float*)F.lds;
    LAS float* WS_ = (LAS float*)(F.lds + 65536);
    LAS float* MU = (LAS float*)(F.lds + 131072);
    LAS float* RSD = MU + 128;
    bf16* U = WSP(bf16, WS_U); const bf16* V = WSP(bf16, WS_V);
    const int lane = F.lane, w = F.wave, tid = F.tid;
    const int nunits = (nrows / 128) * 8;
    for (int unit = F.blk; unit < nunits; unit += F.G) {
        const int c = unit >> 3, g = unit & 7, row0 = c * 128;
        __syncthreads();
        for (int i = 0; i < 16; ++i) { const int s = w * 16 + i; const bf16* vr = V + (size_t)(row0 + s) * 1024;
            const v4u a = *(const v4u*)(vr + lane * 8), b = *(const v4u*)(vr + 512 + lane * 8);
            float sm = 0.f, sq = 0.f;
#define SGU_ACC(u_) { const float x0 = bf_lo(u_), x1 = bf_hi(u_); sm += x0 + x1; sq += x0 * x0 + x1 * x1; }
            SGU_ACC(a.x) SGU_ACC(a.y) SGU_ACC(a.z) SGU_ACC(a.w) SGU_ACC(b.x) SGU_ACC(b.y) SGU_ACC(b.z) SGU_ACC(b.w)
#undef SGU_ACC
            sm = wave_sum(sm); sq = wave_sum(sq);
            const float mean = sm * (1.0f / 1024.0f); const float var = fmaxf(sq * (1.0f / 1024.0f) - mean * mean, 0.f);
            if (lane == 0) { MU[s] = mean; RSD[s] = rsqrtf(var + EPS); } }
        __syncthreads();
        const float* lng = F.ln_g + l * 1024 + g * 128; const float* lnb = F.ln_b + l * 1024 + g * 128;
#pragma unroll
        for (int j = 0; j < 4; ++j) { const int p = tid + 512 * j, s = p >> 4, c8 = (p & 15) * 8;
            const v4u a = *(const v4u*)(V + (size_t)(row0 + s) * 1024 + g * 128 + c8);
            const f32x4 g0 = *(const f32x4*)(lng + c8), g1 = *(const f32x4*)(lng + c8 + 4), b0 = *(const f32x4*)(lnb + c8), b1 = *(const f32x4*)(lnb + c8 + 4);
            const float mu = MU[s], rs = RSD[s];
            f32x4 t0, t1;
            t0[0] = (bf_lo(a.x) - mu) * rs * g0[0] + b0[0]; t0[1] = (bf_hi(a.x) - mu) * rs * g0[1] + b0[1]; t0[2] = (bf_lo(a.y) - mu) * rs * g0[2] + b0[2]; t0[3] = (bf_hi(a.y) - mu) * rs * g0[3] + b0[3];
            t1[0] = (bf_lo(a.z) - mu) * rs * g1[0] + b1[0]; t1[1] = (bf_hi(a.z) - mu) * rs * g1[1] + b1[1]; t1[2] = (bf_lo(a.w) - mu) * rs * g1[2] + b1[2]; t1[3] = (bf_hi(a.w) - mu) * rs * g1[3] + b1[3];
            *(LAS f32x4*)(T + s * 128 + c8) = t0; *(LAS f32x4*)(T + s * 128 + c8 + 4) = t1; }
        const float* wsrc = F.sgu_w + (size_t)(l * 8 + g) * 16384;
#pragma unroll
        for (int j = 0; j < 8; ++j) { const int p = tid + 512 * j; *(LAS f32x4*)(WS_ + p * 4) = *(const f32x4*)(wsrc + p * 4); }
        __syncthreads();
        const int cc = lane + 64 * (w & 1), t0r = (w >> 1) * 32;
        float acc[32];
#pragma unroll
        for (int e = 0; e < 32; ++e) acc[e] = 0.f;
#pragma unroll 1
        for (int s4 = 0; s4 < 32; ++s4) { const float x0 = T[(s4 * 4) * 128 + cc], x1 = T[(s4 * 4 + 1) * 128 + cc], x2 = T[(s4 * 4 + 2) * 128 + cc], x3 = T[(s4 * 4 + 3) * 128 + cc];
#pragma unroll
            for (int e = 0; e < 32; ++e) { const f32x4 wv = *(const LAS f32x4*)(WS_ + (t0r + e) * 128 + s4 * 4); acc[e] += (wv[0] * x0 + wv[1] * x1) + (wv[2] * x2 + wv[3] * x3); } }
        const float* bs = F.sgu_b + (l * 8 + g) * 128;
#pragma unroll
        for (int e = 0; e < 32; ++e) { const int t = t0r + e; bf16* up = U + (size_t)(row0 + t) * 1024 + g * 128 + cc; *up = f2bf(bf1(*up) * (acc[e] + bs[t])); }
    }
}

__device__ __forceinline__ void phase_ob(Ctx& F, int l, int nrows) {
    const bf16* OFp = WSP(bf16, WS_OF); const bf16* OBp = WSP(bf16, WS_OB); bf16* R = WSP(bf16, WS_R);
    const float* gg = F.gla_g + l * 1024 + F.lane * 16;
    f32x4 g4[4];
#pragma unroll
    for (int j = 0; j < 4; ++j) g4[j] = *(const f32x4*)(gg + 4 * j);
    for (int m = F.blk * NWAVES + F.wave; m < nrows; m += F.G * NWAVES) {
        const size_t off = (size_t)m * 1024 + F.lane * 16;
        const v4u a0 = *(const v4u*)(OFp + off), a1 = *(const v4u*)(OFp + off + 8), b0 = *(const v4u*)(OBp + off), b1 = *(const v4u*)(OBp + off + 8);
        const v4u r0 = *(const v4u*)(R + off), r1 = *(const v4u*)(R + off + 8);
        float o[16];
#define OB_SUM(i_, ua, ub) o[i_] = bf_lo(ua) + bf_lo(ub); o[i_ + 1] = bf_hi(ua) + bf_hi(ub);
        OB_SUM(0, a0.x, b0.x) OB_SUM(2, a0.y, b0.y) OB_SUM(4, a0.z, b0.z) OB_SUM(6, a0.w, b0.w) OB_SUM(8, a1.x, b1.x) OB_SUM(10, a1.y, b1.y) OB_SUM(12, a1.z, b1.z) OB_SUM(14, a1.w, b1.w)
#undef OB_SUM
        float ss = 0.f;
#pragma unroll
        for (int i = 0; i < 16; ++i) ss += o[i] * o[i];
        ss += __shfl_xor(ss, 1); ss += __shfl_xor(ss, 2); ss += __shfl_xor(ss, 4); ss += __shfl_xor(ss, 8);
        const float rn = rsqrtf(ss * (1.0f / 256.0f) + EPS);
        float rv[16];
        rv[0] = bf_lo(r0.x); rv[1] = bf_hi(r0.x); rv[2] = bf_lo(r0.y); rv[3] = bf_hi(r0.y); rv[4] = bf_lo(r0.z); rv[5] = bf_hi(r0.z); rv[6] = bf_lo(r0.w); rv[7] = bf_hi(r0.w);
        rv[8] = bf_lo(r1.x); rv[9] = bf_hi(r1.x); rv[10] = bf_lo(r1.y); rv[11] = bf_hi(r1.y); rv[12] = bf_lo(r1.z); rv[13] = bf_hi(r1.z); rv[14] = bf_lo(r1.w); rv[15] = bf_hi(r1.w);
#pragma unroll
        for (int i = 0; i < 16; ++i) o[i] = o[i] * rn * g4[i >> 2][i & 3] * rv[i];
        v4u w0, w1; w0.x = pk2(o[0], o[1]); w0.y = pk2(o[2], o[3]); w0.z = pk2(o[4], o[5]); w0.w = pk2(o[6], o[7]);
        w1.x = pk2(o[8], o[9]); w1.y = pk2(o[10], o[11]); w1.z = pk2(o[12], o[13]); w1.w = pk2(o[14], o[15]);
        *(v4u*)(R + off) = w0; *(v4u*)(R + off + 8) = w1;
    }
}

__device__ __forceinline__ void phase_router(Ctx& F, int l, int nrows) {
    LAS float* WR = (LAS float*)F.lds;
    LAS int* HIST = (LAS int*)(F.lds + 65536);
    for (int i = F.tid; i < 16384; i += NTHR) { const int k = i >> 4, e = i & 15; WR[e * 1024 + k] = F.w_router[i]; }
    if (F.tid < 16) HIST[F.tid] = 0;
    __syncthreads();
    const float* MODl = WSP(float, WS_MOD) + (size_t)l * 9 * 6144; const float* g2 = F.g2 + l * D;
    bf16* H2 = WSP(bf16, WS_H2); int* EID = WSP(int, WS_EID); float* WGT = WSP(float, WS_WGT); const float* CTXS = WSP(float, WS_CTXS);
    const int rpb = (nrows + F.G - 1) / F.G, r_lo = F.blk * rpb, r_hi = (r_lo + rpb < nrows) ? r_lo + rpb : nrows;
    for (int m = r_lo + F.wave; m < r_hi; m += NWAVES) {
        const int mb = m < NLAT ? (m >> 12) : 8;
        const float* xr = (m < NLAT) ? F.out + (size_t)m * D : CTXS + (size_t)(m - NLAT) * D;
        const float* sh = MODl + mb * 6144 + 3 * 1024; const float* sc = sh + 1024;
        f32x4 v[4]; float ss = 0.f;
#pragma unroll
        for (int j = 0; j < 4; ++j) { v[j] = *(const f32x4*)(xr + 4 * F.lane + 256 * j); ss += (v[j][0] * v[j][0] + v[j][1] * v[j][1]) + (v[j][2] * v[j][2] + v[j][3] * v[j][3]); }
        const float rstd = rsqrtf(wave_sum(ss) * (1.0f / D) + EPS);
#pragma unroll
        for (int j = 0; j < 4; ++j) { const int k = 4 * F.lane + 256 * j;
            const f32x4 g = *(const f32x4*)(g2 + k), s1 = *(const f32x4*)(sc + k), s0 = *(const f32x4*)(sh + k);
            v[j] = v[j] * rstd * g * (s1 + 1.0f) + s0;
            v2u o; o.x = pk2(v[j][0], v[j][1]); o.y = pk2(v[j][2], v[j][3]);
            *(v2u*)(H2 + (size_t)m * D + k) = o; }
        float lg[16];
#pragma unroll
        for (int e = 0; e < 16; ++e) { float p = 0.f;
#pragma unroll
            for (int j = 0; j < 4; ++j) { const f32x4 wv = *(const LAS f32x4*)(WR + e * 1024 + 4 * F.lane + 256 * j); p += (v[j][0] * wv[0] + v[j][1] * wv[1]) + (v[j][2] * wv[2] + v[j][3] * wv[3]); }
            lg[e] = wave_sum(p) + F.b_router[e]; }
        float mx = lg[0];
#pragma unroll
        for (int e = 1; e < 16; ++e) mx = fmaxf(mx, lg[e]);
        float p[16];
#pragma unroll
        for (int e = 0; e < 16; ++e) p[e] = __expf(lg[e] - mx);
        int gsel = 0; float gbest = -1.f;
#pragma unroll
        for (int g = 0; g < 4; ++g) { const float a = p[4 * g], b = p[4 * g + 1], c = p[4 * g + 2], d = p[4 * g + 3];
            const float hi1 = fmaxf(a, b), lo1 = fminf(a, b), hi2 = fmaxf(c, d), lo2 = fminf(c, d);
            const float top = fmaxf(hi1, hi2), second = fmaxf(fminf(hi1, hi2), fmaxf(lo1, lo2));
            const float sc_ = top + second; if (sc_ > gbest) { gbest = sc_; gsel = g; } }
        float q[4];
#pragma unroll
        for (int i = 0; i < 4; ++i) q[i] = gsel == 0 ? p[i] : gsel == 1 ? p[4 + i] : gsel == 2 ? p[8 + i] : p[12 + i];
        int i1 = 0; float p1 = q[0];
#pragma unroll
        for (int i = 1; i < 4; ++i) if (q[i] > p1) { p1 = q[i]; i1 = i; }
        int i2 = -1; float p2 = -1.f;
#pragma unroll
        for (int i = 0; i < 4; ++i) if (i != i1 && q[i] > p2) { p2 = q[i]; i2 = i; }
        const float inv = 1.0f / (p1 + p2);
        if (F.lane == 0) { EID[2 * m] = gsel * 4 + i1; EID[2 * m + 1] = gsel * 4 + i2; WGT[2 * m] = p1 * inv; WGT[2 * m + 1] = p2 * inv;
            atomicAdd((int*)(HIST + gsel * 4 + i1), 1); atomicAdd((int*)(HIST + gsel * 4 + i2), 1); }
    }
    __syncthreads();
    if (F.tid < 16) WSP(int, WS_HISTG)[F.blk * 16 + F.tid] = HIST[F.tid];
}

__device__ __forceinline__ void phase_scatter(Ctx& F, int nrows) {
    LAS int* CNT = (LAS int*)F.lds;
    LAS int* BASE = CNT + 16;
    LAS int* PST = CNT + 32;
    LAS int* ES = CNT + 64;
    LAS int* POS = CNT + 64 + 1024;
    const int* HISTG = WSP(int, WS_HISTG); const int* EID = WSP(int, WS_EID); int* SPOS = WSP(int, WS_SPOS); int* TILEE = WSP(int, WS_TILEE);
    __syncthreads();
    if (F.tid < 16) { int tot = 0, mine = 0; for (int b = 0; b < F.G; ++b) { const int v = HISTG[b * 16 + F.tid]; tot += v; if (b < F.blk) mine += v; } CNT[F.tid] = tot; BASE[F.tid] = mine; }
    __syncthreads();
    if (F.tid == 0) { int p = 0; for (int e = 0; e < 16; ++e) { PST[e] = p; const int nt = (CNT[e] + 255) >> 8;
            if (F.blk == 0) for (int t = 0; t < nt; ++t) TILEE[16 + (p >> 8) + t] = e;
            p += nt << 8; }
        if (F.blk == 0) TILEE[0] = p >> 8; }
    const int rpb = (nrows + F.G - 1) / F.G, r_lo = F.blk * rpb, r_hi = (r_lo + rpb < nrows) ? r_lo + rpb : nrows;
    const int nslots = (r_hi > r_lo) ? 2 * (r_hi - r_lo) : 0;
    for (int q = F.tid; q < nslots; q += NTHR) ES[q] = EID[2 * r_lo + q];
    __syncthreads();
    for (int q = F.tid; q < nslots; q += NTHR) { const int e = ES[q]; int rank = 0; for (int q2 = 0; q2 < q; ++q2) rank += (ES[q2] == e) ? 1 : 0;
        const int pos = PST[e] + BASE[e] + rank; POS[q] = pos; SPOS[2 * r_lo + q] = pos; }
    __syncthreads();
    const bf16* H2 = WSP(bf16, WS_H2); bf16* XG = WSP(bf16, WS_XG);
    for (int q = F.wave; q < nslots; q += NWAVES) { const bf16* src = H2 + (size_t)(r_lo + (q >> 1)) * D + F.lane * 16; bf16* dst = XG + (size_t)POS[q] * D + F.lane * 16;
        const v4u a = *(const v4u*)src, b = *(const v4u*)(src + 8); *(v4u*)dst = a; *(v4u*)(dst + 8) = b; }
}

typedef __attribute__((address_space(4))) const unsigned char* KARGP;
__device__ __forceinline__ unsigned long long karg_q(int off) { asm volatile("" : "+s"(off)); return *(const __attribute__((address_space(4))) unsigned long long*)((KARGP)__builtin_amdgcn_kernarg_segment_ptr() + off); }
__device__ __forceinline__ Ctx mk_ctx(LAS unsigned char* lds) {
    Ctx F; F.lds = lds; F.ws = (unsigned char*)(GAS unsigned char*)karg_q(27 * 8); F.out = (float*)(GAS float*)karg_q(26 * 8);
    F.tid = opaque_v((int)threadIdx.x); F.lane = F.tid & 63; F.wave = __builtin_amdgcn_readfirstlane(F.tid >> 6); F.G = gridDim.x; F.blk = blockIdx.x;
#define KIN(k) ((const float*)(GAS const float*)karg_q((k) * 8))
    F.x = KIN(0); F.c = KIN(1); F.ctx = KIN(2); F.c_ctx = KIN(3); F.w_mod = KIN(4); F.b_mod = KIN(5); F.g1 = KIN(6); F.g2 = KIN(7);
    F.w_in = KIN(8); F.w_gate2 = KIN(9); F.b_gate2 = KIN(10); F.gla_g = KIN(11); F.ln_g = KIN(12); F.ln_b = KIN(13); F.sgu_w = KIN(14); F.sgu_b = KIN(15);
    F.w_a = KIN(16); F.w_b = KIN(17); F.b_branch = KIN(18); F.w_out = KIN(19); F.w_router = KIN(20); F.b_router = KIN(21);
    F.w_eg = KIN(22); F.w_eu = KIN(23); F.w_ed = KIN(24); F.g_final = KIN(25);
#undef KIN
    return F;
}
struct Args { const float* in[26]; float* out; unsigned char* ws; int ph_lo, ph_hi; };
constexpr int NPHASE = 2 + 12 * DEPTH;

#if MK_SPLIT
#define GRID_BAR() do { } while (0)
#else
#define GRID_BAR() do { XcdBarrier b_ = bar; asm volatile("" : "+s"(b_.x)); unsigned long long p_ = (unsigned long long)b_.bar; asm volatile("" : "+s"(p_)); b_.bar = (unsigned*)(GAS unsigned*)p_; xcd_barrier(b_); } while (0)
#endif
#ifndef PH_KIND
#define PH_KIND (-1)
#endif
#define KON(j) (PH_KIND < 0 || PH_KIND == (j))
#define IN(k) (lo <= (k) && (k) < hi)
#define SEAM(k) do { if (IN(k) && IN((k) + 1)) GRID_BAR(); } while (0)
template <int l>
__device__ __forceinline__ void layer_body(LAS unsigned char* const ldsb, const int lo, const int hi, const XcdBarrier& bar) {

        const int pb = 2 + 12 * l;
        const bool wctx = l < DEPTH - 1;
        const int nrow_m = wctx ? NTOK : NLAT;
        if (KON(0) && IN(pb + 0)) { Ctx F = mk_ctx(ldsb); LAS unsigned char* ring = F.lds;
            pg8::SchedPlain S; S.o.init(NTOK / 256, 16, F.G, F.blk); S.A = (const char*)WSP(bf16, WS_H); S.B = (const char*)(WSP(bf16, WS_W1T) + (size_t)l * 4096 * 1024); S.tstep = (size_t)256 * 1024 * 2;
            EpiI1 E{WSP(bf16, WS_U), WSP(bf16, WS_V), WSP(bf16, WS_Q), WSP(bf16, WS_K), WSP(bf16, WS_VV)};
            pg8::gemm_phase<EpiI1, pg8::SchedPlain, true, true>(ring, 1024, S, E);
        } SEAM(pb + 0);
        if (KON(1) && IN(pb + 1)) { Ctx F = mk_ctx(ldsb); LAS unsigned char* ring = F.lds; phase_gla(F, l); } SEAM(pb + 1);
        if (KON(2) && IN(pb + 2)) { Ctx F = mk_ctx(ldsb); LAS unsigned char* ring = F.lds; phase_sgu(F, l, nrow_m); } SEAM(pb + 2);
        if (KON(3) && IN(pb + 3)) { Ctx F = mk_ctx(ldsb); LAS unsigned char* ring = F.lds;
            pg8::SchedPlain S; S.o.init(nrow_m / 256, 12, F.G, F.blk); S.A = (const char*)WSP(bf16, WS_H); S.B = (const char*)(WSP(bf16, WS_W2T) + (size_t)l * 3072 * 1024); S.tstep = (size_t)256 * 1024 * 2;
            EpiI2 E{WSP(bf16, WS_R), WSP(bf16, WS_GR), WSP(bf16, WS_GB), F.b_branch + l * 2048};
            pg8::gemm_phase<EpiI2, pg8::SchedPlain, true, true>(ring, 1024, S, E);
        } SEAM(pb + 3);
        if (KON(4) && IN(pb + 4)) { Ctx F = mk_ctx(ldsb); LAS unsigned char* ring = F.lds; phase_ob(F, l, nrow_m); } SEAM(pb + 4);
        if (KON(5) && IN(pb + 5)) { Ctx F = mk_ctx(ldsb); LAS unsigned char* ring = F.lds;
            pg8::SchedDual S; S.o.init(nrow_m / 256, 4, F.G, F.blk); S.tstep = (size_t)256 * 1024 * 2;
            S.A0 = (const char*)WSP(bf16, WS_U); S.B0 = (const char*)(WSP(bf16, WS_WA) + (size_t)l * D * D);
            S.A1 = (const char*)WSP(bf16, WS_R); S.B1 = (const char*)(WSP(bf16, WS_WB) + (size_t)l * D * D);
            EpiM1 E{WSP(bf16, WS_GR), WSP(bf16, WS_GB), WSP(bf16, WS_MB)};
            pg8::gemm_phase<EpiM1, pg8::SchedDual, true, true>(ring, 1024, S, E);
        } SEAM(pb + 5);
        if (KON(6) && IN(pb + 6)) { Ctx F = mk_ctx(ldsb); LAS unsigned char* ring = F.lds;
            pg8::SchedPlain S; S.o.init(nrow_m / 256, 4, F.G, F.blk); S.A = (const char*)WSP(bf16, WS_MB); S.B = (const char*)(WSP(bf16, WS_WO) + (size_t)l * D * D); S.tstep = (size_t)256 * 1024 * 2;
            EpiM2 E{l == 0 ? F.x : F.out, l == 0 ? F.ctx : WSP(float, WS_CTXS), F.out, WSP(float, WS_CTXS), WSP(float, WS_MOD) + (size_t)l * 9 * 6144};
            pg8::gemm_phase<EpiM2, pg8::SchedPlain, true, true>(ring, 1024, S, E);
        } SEAM(pb + 6);
        if (KON(7) && IN(pb + 7)) { Ctx F = mk_ctx(ldsb); LAS unsigned char* ring = F.lds; phase_router(F, l, nrow_m); } SEAM(pb + 7);
        if (KON(8) && IN(pb + 8)) { Ctx F = mk_ctx(ldsb); LAS unsigned char* ring = F.lds; phase_scatter(F, nrow_m); } SEAM(pb + 8);
        if (KON(9) && IN(pb + 9)) { Ctx F = mk_ctx(ldsb); LAS unsigned char* ring = F.lds;
            const int* TILEE = WSP(int, WS_TILEE); const int ntiles = TILEE[0];
            pg8::SchedMoe S; S.o.init(ntiles, 12, F.G, F.blk); S.A = (const char*)WSP(bf16, WS_XG); S.B = (const char*)WSP(bf16, WS_WGU); S.tstep = (size_t)256 * 1024 * 2; S.estride = (size_t)3072 * 1024 * 2; S.tile_e = TILEE + 16;
            EpiG1 E{WSP(bf16, WS_HH)};
            pg8::gemm_phase<EpiG1, pg8::SchedMoe, true, true>(ring, 1024, S, E);
        } SEAM(pb + 9);
        if (KON(10) && IN(pb + 10)) { Ctx F = mk_ctx(ldsb); LAS unsigned char* ring = F.lds;
            const int* TILEE = WSP(int, WS_TILEE); const int ntiles = TILEE[0];
            pg8::SchedMoe S; S.o.init(ntiles, 4, F.G, F.blk); S.A = (const char*)WSP(bf16, WS_HH); S.B = (const char*)WSP(bf16, WS_WD); S.tstep = (size_t)256 * DEXP * 2; S.estride = (size_t)1024 * DEXP * 2; S.tile_e = TILEE + 16;
            EpiG2 E{WSP(bf16, WS_XG)};
            pg8::gemm_phase<EpiG2, pg8::SchedMoe, true, true>(ring, DEXP, S, E);
        } SEAM(pb + 10);
        if (KON(11) && IN(pb + 11)) { Ctx F = mk_ctx(ldsb); LAS unsigned char* ring = F.lds;
            if (wctx) { phase_rows<1>(F, l, l + 1); __syncthreads(); convert_experts(F, l + 1, F.blk * NWAVES + F.wave, F.G * NWAVES); }
            else phase_rows<2>(F, l, l);
        }
        if (l + 1 < DEPTH) SEAM(pb + 11);
    }
__global__ void __launch_bounds__(NTHR, 2) mega_fwd(Args args) {
    extern __shared__ __attribute__((aligned(16))) unsigned char lds[];
    LAS unsigned char* const ldsb = (LAS unsigned char*)lds;
    volatile LAS unsigned* MISC = (volatile LAS unsigned*)(ldsb + MISC_OFF);
    if (threadIdx.x < 64) MISC[threadIdx.x] = 0u;
    __syncthreads();
    unsigned* ctl = (unsigned*)(args.ws + WS_CTL);
#if MK_SPLIT
    XcdBarrier bar; bar.bar = ctl + CW_BAR; bar.x = 0; bar.st = MISC + 8;
#else
    XcdBarrier bar = xcd_barrier_post(ctl + CW_BAR, MISC + 8);
#endif
    const int lo = args.ph_lo, hi = args.ph_hi;

    if (KON(12) && IN(0)) { Ctx F = mk_ctx(ldsb); p0_prologue(F); } SEAM(0);
    if (KON(13) && IN(1)) { Ctx F = mk_ctx(ldsb); phase_rows<0>(F, 0, 0); } SEAM(1);

    layer_body<0>(ldsb, lo, hi, bar);
    layer_body<1>(ldsb, lo, hi, bar);
#undef IN
#undef SEAM
}

extern "C" void kernel_launch(void* const* d_in, const int* in_sizes, int n_in, void* d_out, int out_size, void* d_ws, size_t ws_size, hipStream_t stream) {
    static int grid = 0;
    if (grid == 0) {
        if (n_in != 26 || in_sizes[0] != NLAT * D || out_size != NLAT * D || ws_size < WS_END) { fprintf(stderr, "kernel_launch: unexpected problem (n_in %d, ws %zu < %zu)\n", n_in, ws_size, (size_t)WS_END); grid = -1; return; }
        int dev = 0, cus = 0;
        if (hipGetDevice(&dev) != hipSuccess || hipDeviceGetAttribute(&cus, hipDeviceAttributeMultiprocessorCount, dev) != hipSuccess) { grid = -1; return; }
        if (hipFuncSetAttribute((const void*)mega_fwd, hipFuncAttributeMaxDynamicSharedMemorySize, LDS_BYTES) != hipSuccess) { fprintf(stderr, "kernel_launch: hipFuncSetAttribute failed\n"); grid = -1; return; }
        int per_cu = 0;
        if (hipOccupancyMaxActiveBlocksPerMultiprocessor(&per_cu, (const void*)mega_fwd, NTHR, LDS_BYTES) != hipSuccess || per_cu < 1) fprintf(stderr, "kernel_launch: occupancy query reports %d\n", per_cu);
        (void)hipGetLastError();
        grid = cus;
    }
    if (grid < 0) return;
    if (hipMemsetAsync((char*)d_ws + WS_CTL, 0, CTL_ZERO_BYTES, stream) != hipSuccess) return;
    Args a{};
    for (int i = 0; i < 26; ++i) a.in[i] = (const float*)d_in[i];
    a.out = (float*)d_out; a.ws = (unsigned char*)d_ws;
#if MK_SPLIT
    for (int p = 0; p < NPHASE; ++p) { a.ph_lo = p; a.ph_hi = p + 1; hipLaunchKernelGGL(mega_fwd, dim3(grid), dim3(NTHR), LDS_BYTES, stream, a); }
#else
    a.ph_lo = 0; a.ph_hi = NPHASE;
    hipLaunchKernelGGL(mega_fwd, dim3(grid), dim3(NTHR), LDS_BYTES, stream, a);
#endif
}
```

```cpp
#include <hip/hip_runtime.h>
#include <cstdio>
#include <cstdint>

#ifndef MK_SPLIT
#define MK_SPLIT 0
#endif

namespace pg8 {
#define PG8_LAS __attribute__((address_space(3)))
typedef unsigned short bf16_t;
typedef short bf16x8 __attribute__((ext_vector_type(8)));
typedef float f32x4 __attribute__((ext_vector_type(4)));
typedef float f32x2 __attribute__((ext_vector_type(2)));
typedef unsigned u32x4 __attribute__((ext_vector_type(4)));
constexpr int BM = 256, BK = 64, HALF = 128, HTB = HALF * BK * 2, STAGE_BYTES = 8 * HTB, NXCD = 8, WGM = 8;

__host__ __device__ __forceinline__ int lds_byte(int r, int c) { const int st = (r >> 4) * 2 + (c >> 5), rr = r & 15, cc = c & 31, ob = rr * 64 + cc * 2; return st * 1024 + (ob ^ (((ob >> 9) & 1) << 5)); }
__host__ __device__ __forceinline__ void stage_rc(int b, int& R, int& C) { const int st = b / 1024, sb = b % 1024, swz = sb ^ (((sb >> 9) & 1) << 5); R = (st >> 1) * 16 + swz / 64; C = (st & 1) * 32 + (swz % 64) / 2; }
__host__ __device__ __forceinline__ int perm32(int rho) { const int n = rho >> 4, i = rho & 15; return 8 * (i >> 2) + 4 * n + (i & 3); }

struct Unit { int pm, pn, sub, e; const char* a; const char* b; };

struct StaticOrder {
    int nM, nN, nwg, G, c;
    __device__ __forceinline__ void init(int nM_, int nN_, int G_, int c_) { nM = nM_; nN = nN_; nwg = nM * nN; G = G_; c = c_; }
    __device__ __forceinline__ bool tile(int i, int& pm, int& pn) const {
        const long L = (long)i * G + c; if (L >= nwg) return false;
        int wgid = (int)L; { const int q = nwg / NXCD, r = nwg % NXCD, xcd = wgid % NXCD, off = wgid / NXCD; wgid = (xcd < r ? xcd * (q + 1) : r * (q + 1) + (xcd - r) * q) + off; }
        const int nig = WGM * nN, gid = wgid / nig, fm = gid * WGM, gsz = (nM - fm) < WGM ? (nM - fm) : WGM;
        pm = fm + ((wgid % nig) % gsz); pn = (wgid % nig) / gsz; return true;
    }
};
struct SchedPlain {
    StaticOrder o; const char* A; const char* B; size_t tstep;
    __device__ __forceinline__ bool next(int i, Unit& u) const { if (!o.tile(i, u.pm, u.pn)) return false; u.sub = 0; u.e = 0; u.a = A + (size_t)u.pm * tstep; u.b = B + (size_t)u.pn * tstep; return true; }
};
struct SchedDual {
    StaticOrder o; const char* A0; const char* B0; const char* A1; const char* B1; size_t tstep;
    __device__ __forceinline__ bool next(int i, Unit& u) const { if (!o.tile(i >> 1, u.pm, u.pn)) return false; u.sub = i & 1; u.e = 0;
        u.a = (u.sub ? A1 : A0) + (size_t)u.pm * tstep; u.b = (u.sub ? B1 : B0) + (size_t)u.pn * tstep; return true; }
};
struct SchedMoe {
    StaticOrder o; const char* A; const char* B; size_t tstep; size_t estride; const int* tile_e;
    __device__ __forceinline__ bool next(int i, Unit& u) const { if (!o.tile(i, u.pm, u.pn)) return false; u.sub = 0; u.e = tile_e[u.pm];
        u.a = A + (size_t)u.pm * tstep; u.b = B + (size_t)u.e * estride + (size_t)u.pn * tstep; return true; }
};

__device__ __forceinline__ unsigned cvt_pk_bf16(float lo, float hi) { unsigned r; asm volatile("v_cvt_pk_bf16_f32 %0, %1, %2" : "=v"(r) : "v"(lo), "v"(hi)); return r; }

template <class Epi, class Sched, bool ALIGN_EPI, bool SP2>
__device__ __forceinline__ void gemm_phase(PG8_LAS unsigned char* lds, const int K, const Sched& S, const Epi& E) {
    int tid_ = threadIdx.x; asm volatile("" : "+v"(tid_)); const int tid = tid_, wid = __builtin_amdgcn_readfirstlane(tid >> 6), lane = tid & 63, wr = wid >> 2, wc = wid & 3, fr = lane & 15, fq = lane >> 4;
    const int nt = K / BK;
    unsigned voffA[2], voffB[2];
#pragma unroll
    for (int i = 0; i < 2; ++i) { int R, C; stage_rc(tid * 16 + i * 8192, R, C); const int Rb = Epi::PERM ? ((R & ~31) + perm32(R & 31)) : R;
        voffA[i] = (unsigned)(R * K + C) * 2u; voffB[i] = (unsigned)(Rb * K + C) * 2u; }
    const size_t kstep = (size_t)(BK * 2);
    const size_t hstep = (size_t)HALF * K * 2;
    const unsigned ldsw = (unsigned)wid * 1024u;
    const int aoff = lds_byte(wr * 64 + fr, fq * 8), boff = lds_byte(wc * 32 + fr, fq * 8);
#define PG8_SA(b, h) (((b) * 2 + (h)) * HTB)
#define PG8_SB(b, h) ((4 + (b) * 2 + (h)) * HTB)
#define PG8_STAGE(bufoff, gbase, voff) do { _Pragma("unroll") for (int _i = 0; _i < 2; ++_i) \
        __builtin_amdgcn_global_load_lds((const unsigned*)((const char*)(gbase) + (voff)[_i]), (PG8_LAS unsigned*)(lds + (bufoff) + ldsw + _i * 8192), 16, 0, 0); } while (0)
#define PG8_LDA(dst, b, h) do { _Pragma("unroll") for (int m = 0; m < 4; ++m) _Pragma("unroll") for (int k = 0; k < 2; ++k) dst[m][k] = *(const PG8_LAS bf16x8*)(lds + PG8_SA(b, h) + aoff + m * 2048 + k * 1024); } while (0)
#define PG8_LDB(dst, b, h) do { _Pragma("unroll") for (int n = 0; n < 2; ++n) _Pragma("unroll") for (int k = 0; k < 2; ++k) dst[n][k] = *(const PG8_LAS bf16x8*)(lds + PG8_SB(b, h) + boff + n * 2048 + k * 1024); } while (0)
#define PG8_MMA(ai, bj, At, Bt) do { __builtin_amdgcn_s_setprio(1); _Pragma("unroll") for (int m = 0; m < 4; ++m) _Pragma("unroll") for (int n = 0; n < 2; ++n) _Pragma("unroll") for (int k = 0; k < 2; ++k) \
        acc[ai][bj][m][n] = __builtin_amdgcn_mfma_f32_16x16x32_bf16(Bt[n][k], At[m][k], acc[ai][bj][m][n], 0, 0, 0); __builtin_amdgcn_s_setprio(0); } while (0)
#define PG8_WAIT_V(n) asm volatile("s_waitcnt vmcnt(" #n ")" ::: "memory")
#define PG8_WAIT_L(n) asm volatile("s_waitcnt lgkmcnt(" #n ")" ::: "memory")
#define PG8_BAR __builtin_amdgcn_s_barrier()
#define PG8_SCHED __builtin_amdgcn_sched_barrier(0)
    Unit cur, nxt; int ui = 0;
    if (!S.next(0, cur)) return;
    f32x4 acc[2][2][4][2];
#pragma unroll
    for (int a = 0; a < 2; ++a)
#pragma unroll
        for (int b = 0; b < 2; ++b)
#pragma unroll
            for (int m = 0; m < 4; ++m)
#pragma unroll
                for (int n = 0; n < 2; ++n) acc[a][b][m][n] = (f32x4){0.f, 0.f, 0.f, 0.f};
    bf16x8 At[4][2], B0[2][2], B1[2][2];
    const char* cA = cur.a; const char* cB = cur.b;
    if constexpr (SP2) {
        PG8_STAGE(PG8_SB(0, 0), cB, voffB); PG8_STAGE(PG8_SB(0, 1), cB + hstep, voffB); PG8_STAGE(PG8_SA(0, 0), cA, voffA); PG8_STAGE(PG8_SA(0, 1), cA + hstep, voffA);
        if (wr == 1) PG8_BAR;
        PG8_WAIT_V(2); PG8_BAR;
        PG8_STAGE(PG8_SB(1, 0), cB + kstep, voffB); PG8_STAGE(PG8_SA(1, 0), cA + kstep, voffA); PG8_STAGE(PG8_SB(1, 1), cB + hstep + kstep, voffB);
        PG8_WAIT_V(6); PG8_BAR;
    } else {
        PG8_STAGE(PG8_SB(0, 0), cB, voffB); PG8_STAGE(PG8_SA(0, 0), cA, voffA); PG8_STAGE(PG8_SB(0, 1), cB + hstep, voffB); PG8_STAGE(PG8_SA(0, 1), cA + hstep, voffA);
        if (wr == 1) PG8_BAR;
        PG8_WAIT_V(4); PG8_BAR;
        PG8_STAGE(PG8_SB(1, 0), cB + kstep, voffB); PG8_STAGE(PG8_SA(1, 0), cA + kstep, voffA); PG8_STAGE(PG8_SB(1, 1), cB + hstep + kstep, voffB);
        PG8_WAIT_V(6); PG8_BAR;
    }
    for (;;) {
        const bool has_next = S.next(ui + 1, nxt);
        const char* nA = has_next ? nxt.a : cA; const char* nB = has_next ? nxt.b : cB;
        for (int t = 0; t < nt; t += 2) {
            const bool last = (t == nt - 2);
            const char* a1 = cA + (size_t)(t + 1) * kstep;
            const char* a2 = last ? nA : cA + (size_t)(t + 2) * kstep; const char* b2 = last ? nB : cB + (size_t)(t + 2) * kstep;
            const char* a3 = a2 + kstep; const char* b3 = b2 + kstep;
            if constexpr (SP2) {
            PG8_LDB(B0, 0, 0); PG8_LDB(B1, 0, 1); PG8_SCHED; PG8_LDA(At, 0, 0); PG8_STAGE(PG8_SA(1, 1), a1 + hstep, voffA);
            PG8_WAIT_V(8); PG8_WAIT_L(0); PG8_BAR; PG8_MMA(0, 0, At, B0); PG8_MMA(0, 1, At, B1); PG8_BAR; PG8_SCHED;
            PG8_LDA(At, 0, 1); PG8_STAGE(PG8_SB(0, 0), b2, voffB); PG8_STAGE(PG8_SB(0, 1), b2 + hstep, voffB); PG8_STAGE(PG8_SA(0, 0), a2, voffA);
            PG8_WAIT_V(8); PG8_WAIT_L(0); PG8_BAR; PG8_MMA(1, 0, At, B0); PG8_MMA(1, 1, At, B1); PG8_BAR; PG8_SCHED;
            PG8_LDB(B0, 1, 0); PG8_LDB(B1, 1, 1); PG8_SCHED; PG8_LDA(At, 1, 0); PG8_STAGE(PG8_SA(0, 1), a2 + hstep, voffA);
            PG8_WAIT_V(8); PG8_WAIT_L(0); PG8_BAR; PG8_MMA(0, 0, At, B0); PG8_MMA(0, 1, At, B1); PG8_BAR; PG8_SCHED;
            PG8_LDA(At, 1, 1); PG8_STAGE(PG8_SB(1, 0), b3, voffB); PG8_STAGE(PG8_SB(1, 1), b3 + hstep, voffB); PG8_STAGE(PG8_SA(1, 0), a3, voffA);
            PG8_WAIT_V(8); PG8_WAIT_L(0); PG8_BAR; PG8_MMA(1, 0, At, B0); PG8_MMA(1, 1, At, B1); PG8_BAR; PG8_SCHED;
            } else {
            PG8_LDB(B0, 0, 0); PG8_SCHED; PG8_LDA(At, 0, 0); PG8_STAGE(PG8_SA(1, 1), a1 + hstep, voffA);
            PG8_WAIT_L(8); PG8_BAR; PG8_WAIT_L(0); PG8_MMA(0, 0, At, B0); PG8_BAR; PG8_SCHED;
            PG8_LDB(B1, 0, 1); PG8_STAGE(PG8_SB(0, 0), b2, voffB);
            PG8_BAR; PG8_WAIT_L(0); PG8_MMA(0, 1, At, B1); PG8_BAR;
            PG8_LDA(At, 0, 1); PG8_STAGE(PG8_SA(0, 0), a2, voffA);
            PG8_BAR; PG8_WAIT_L(0); PG8_MMA(1, 0, At, B0); PG8_BAR; PG8_SCHED;
            PG8_STAGE(PG8_SB(0, 1), b2 + hstep, voffB);
            PG8_WAIT_V(6); PG8_BAR; PG8_MMA(1, 1, At, B1); PG8_BAR;
            PG8_LDB(B0, 1, 0); PG8_SCHED; PG8_LDA(At, 1, 0); PG8_STAGE(PG8_SA(0, 1), a2 + hstep, voffA);
            PG8_WAIT_L(8); PG8_BAR; PG8_WAIT_L(0); PG8_MMA(0, 0, At, B0); PG8_BAR; PG8_SCHED;
            PG8_LDB(B1, 1, 1); PG8_STAGE(PG8_SB(1, 0), b3, voffB);
            PG8_BAR; PG8_WAIT_L(0); PG8_MMA(0, 1, At, B1); PG8_BAR;
            PG8_LDA(At, 1, 1); PG8_STAGE(PG8_SA(1, 0), a3, voffA);
            PG8_BAR; PG8_WAIT_L(0); PG8_MMA(1, 0, At, B0); PG8_BAR; PG8_SCHED;
            PG8_STAGE(PG8_SB(1, 1), b3 + hstep, voffB);
            PG8_WAIT_V(6); PG8_BAR; PG8_MMA(1, 1, At, B1); PG8_BAR;
            }
        }
        if constexpr (ALIGN_EPI) { if (wr == 0) PG8_BAR; }
        const bool keep = E(acc, cur, wr, wc, fr, fq);
        if (!has_next) break;
        if (!keep) {
#pragma unroll
        for (int a = 0; a < 2; ++a)
#pragma unroll
            for (int b = 0; b < 2; ++b)
#pragma unroll
                for (int m = 0; m < 4; ++m)
#pragma unroll
                    for (int n = 0; n < 2; ++n) acc[a][b][m][n] = (f32x4){0.f, 0.f, 0.f, 0.f};
        }
        cur = nxt; cA = nA; cB = nB; ++ui;
        if constexpr (ALIGN_EPI) { if (wr == 1) PG8_BAR; }
    }
    PG8_WAIT_V(0);
    if constexpr (!ALIGN_EPI) { if (wr == 0) PG8_BAR; }
    PG8_BAR;
#undef PG8_SA
#undef PG8_SB
#undef PG8_STAGE
#undef PG8_LDA
#undef PG8_LDB
#undef PG8_MMA
#undef PG8_WAIT_V
#undef PG8_WAIT_L
#undef PG8_BAR
#undef PG8_SCHED
}
}

constexpr int NWAVES = 8, NTHR = 512;
constexpr int D = 1024, NLAT = 32768, NCTX = 2048, NTOK = NLAT + NCTX, SEQ = 4096, CTXL = 256;
constexpr int INCOLS = 7200, NEXP = 16, DEXP = 1536, DEPTH = 2;
constexpr float EPS = 1e-6f;
constexpr int MPAD = 73728;
constexpr int MAXTILES = MPAD / 256;

constexpr size_t MiB = 1u << 20;
constexpr size_t WS_CTL = 0, CTL_ZERO_BYTES = 1 * MiB;
constexpr size_t WS_MOD = 1 * MiB;
constexpr size_t WS_LR = 2 * MiB;
constexpr size_t WS_EID = 7 * MiB;
constexpr size_t WS_WGT = 7 * MiB + 512 * 1024;
constexpr size_t WS_SPOS = 8 * MiB;
constexpr size_t WS_HISTG = 8 * MiB + 512 * 1024;
constexpr size_t WS_TILEE = 8 * MiB + 768 * 1024;
constexpr size_t WS_WLR = 9 * MiB;
constexpr size_t WS_CTXS = 10 * MiB;
constexpr size_t WS_W1T = 18 * MiB;
constexpr size_t WS_W2T = 34 * MiB;
constexpr size_t WS_WA = 46 * MiB;
constexpr size_t WS_WB = 50 * MiB;
constexpr size_t WS_WO = 54 * MiB;
constexpr size_t WS_WGU = 58 * MiB;
constexpr size_t WS_WD = 154 * MiB;
constexpr size_t WS_ACT = 202 * MiB;
constexpr size_t ROWB = 68 * MiB;
constexpr size_t WS_H = WS_ACT, WS_U = WS_ACT + ROWB, WS_V = WS_ACT + 2 * ROWB, WS_Q = WS_ACT + 3 * ROWB, WS_K = WS_Q + 34 * MiB,
                 WS_VV = WS_ACT + 4 * ROWB, WS_OF = WS_ACT + 5 * ROWB, WS_OB = WS_ACT + 6 * ROWB, WS_END = WS_ACT + 7 * ROWB;
constexpr size_t WS_R = WS_Q, WS_GR = WS_VV, WS_GB = WS_V, WS_MB = WS_OF;
constexpr size_t WS_H2 = WS_H, WS_XG = WS_ACT + ROWB, WS_HH = WS_XG + 144 * MiB;
static_assert(WS_HH + 216 * MiB <= WS_END, "moe overlay");
constexpr int CW_TMO = 0, CW_BAR = 4096;

constexpr int RING_BYTES = 131072;
constexpr int LDS_BYTES = 163840;
constexpr int MISC_OFF = LDS_BYTES - 256;

#define GAS __attribute__((address_space(1)))
#define LAS __attribute__((address_space(3)))
typedef unsigned short bf16;
typedef unsigned v4u __attribute__((ext_vector_type(4)));
typedef unsigned v2u __attribute__((ext_vector_type(2)));
typedef float f32x4 __attribute__((ext_vector_type(4)));
typedef float f32x2 __attribute__((ext_vector_type(2)));
#define LDS_WAIT() asm volatile("s_waitcnt lgkmcnt(0)" ::: "memory")
__device__ __forceinline__ int opaque_v(int v) { asm volatile("" : "+v"(v)); return v; }

__device__ __forceinline__ float bf_lo(unsigned u) { return __uint_as_float(u << 16); }
__device__ __forceinline__ float bf_hi(unsigned u) { return __uint_as_float(u & 0xffff0000u); }
__device__ __forceinline__ float bf1(bf16 b) { return __uint_as_float(((unsigned)b) << 16); }
__device__ __forceinline__ unsigned pk2(float lo, float hi) { return pg8::cvt_pk_bf16(lo, hi); }
__device__ __forceinline__ bf16 f2bf(float f) { return (bf16)(pg8::cvt_pk_bf16(f, 0.f) & 0xffffu); }
__device__ __forceinline__ float wave_sum(float v) {
#pragma unroll
    for (int o = 1; o < 64; o <<= 1) v += __shfl_xor(v, o);
    return v;
}
__device__ __forceinline__ float fsigmoid(float x) { return __builtin_amdgcn_rcpf(1.0f + __expf(-x)); }
__device__ __forceinline__ float fsilu(float x) { return x * fsigmoid(x); }
__device__ __forceinline__ float fgelu_tanh(float x) { const float u = 0.7978845608028654f * (x + 0.044715f * x * x * x); return x * fsigmoid(2.0f * u); }

#define XB_TMO      128
#define XB_XCNT(j)  (256  + 64 * (j))
#define XB_XSUB(j)  (1280 + 64 * (j))
#define XB_XGEN(j)  (2304 + 64 * (j))
#define XB_TOP      3328
#define XB_TOPGEN   3392
#define XCD_BAR_WORDS 3456
#define XB_SPIN_CAP (1u << 18)
__device__ __forceinline__ unsigned xb_ld(unsigned* p)              { return __hip_atomic_load(p, __ATOMIC_RELAXED, __HIP_MEMORY_SCOPE_AGENT); }
__device__ __forceinline__ unsigned xb_add(unsigned* p, unsigned v) { return __hip_atomic_fetch_add(p, v, __ATOMIC_RELAXED, __HIP_MEMORY_SCOPE_AGENT); }
__device__ __forceinline__ unsigned xb_xcc_id() { return (unsigned)__builtin_amdgcn_s_getreg((3 << 11) | 20) & 0xFu; }
#define XB_SPIN(cond, bar) do { unsigned _sp = 0; while (cond) { __builtin_amdgcn_s_sleep(1); \
    if ((++_sp & 255u) == 0u) { if (xb_ld(&(bar)[XB_TMO])) break; if (_sp > XB_SPIN_CAP) { atomicAdd(&(bar)[XB_TMO], 1u); break; } } } } while (0)
struct XcdBarrier { unsigned* bar; unsigned x; volatile LAS unsigned* st; };
__device__ __forceinline__ XcdBarrier xcd_barrier_post(unsigned* bar, volatile LAS unsigned* st) {
    XcdBarrier b; b.bar = bar; b.x = xb_xcc_id(); b.st = st;
    if (threadIdx.x == 0) (void)xb_add(&bar[XB_XCNT(b.x)], 1u);
    return b;
}
__device__ __forceinline__ void xcd_barrier_complete(unsigned* bar, unsigned x, unsigned& nloc, unsigned& nx) {
    const unsigned G = gridDim.x * gridDim.y * gridDim.z;
    unsigned sum, cnt, mine, sp = 0u;
    for (;;) {
        sum = 0u; cnt = 0u; mine = 0u;
#pragma unroll
        for (unsigned j = 0; j < 16; ++j) { const unsigned c = xb_ld(&bar[XB_XCNT(j)]); sum += c; cnt += (c > 0u) ? 1u : 0u; mine = (j == x) ? c : mine; }
        if (sum == G) break;
        __builtin_amdgcn_s_sleep(1);
        if ((++sp & 255u) == 0u) { if (xb_ld(&bar[XB_TMO])) break; if (sp > XB_SPIN_CAP) { atomicAdd(&bar[XB_TMO], 1u); break; } }
    }
    nloc = mine > 0u ? mine : 1u; nx = cnt > 0u ? cnt : 1u;
}
__device__ __forceinline__ void xcd_barrier(const XcdBarrier& b) {
    asm volatile("s_waitcnt vmcnt(0)" ::: "memory");
    __syncthreads();
    if (threadIdx.x == 0) {
        unsigned* bar = b.bar;
        __builtin_amdgcn_s_waitcnt(0);
        unsigned nloc = b.st[0], nx = b.st[1];
        if (nloc == 0u) { xcd_barrier_complete(bar, b.x, nloc, nx); b.st[0] = nloc; b.st[1] = nx; }
        const unsigned old = xb_add(&bar[XB_XSUB(b.x)], 1u);
        const unsigned gen = old / nloc;
        if (old + 1u == (gen + 1u) * nloc) {
            __builtin_amdgcn_fence(__ATOMIC_RELEASE, "agent");
            asm volatile("s_waitcnt vmcnt(0)" ::: "memory");
            const unsigned og = xb_add(&bar[XB_TOP], 1u);
            const unsigned tg = og / nx;
            if (og + 1u == (tg + 1u) * nx) xb_add(&bar[XB_TOPGEN], 1u);
            else XB_SPIN(xb_ld(&bar[XB_TOPGEN]) == tg, bar);
            __builtin_amdgcn_fence(__ATOMIC_ACQUIRE, "agent");
            xb_add(&bar[XB_XGEN(b.x)], 1u);
            asm volatile("s_waitcnt vmcnt(0)" ::: "memory");
        } else {
            XB_SPIN(xb_ld(&bar[XB_XGEN(b.x)]) == gen, bar);
            __builtin_amdgcn_fence(__ATOMIC_ACQUIRE, "agent");
            asm volatile("s_waitcnt vmcnt(0)" ::: "memory");
        }
    }
    __syncthreads();
}

struct Ctx {
    LAS unsigned char* lds;
    unsigned char* ws;
    int tid, lane, wave, G, blk;
    const float *x, *c, *ctx, *c_ctx, *w_mod, *b_mod, *g1, *g2, *w_in, *w_gate2, *b_gate2, *gla_g, *ln_g, *ln_b, *sgu_w, *sgu_b,
                *w_a, *w_b, *b_branch, *w_out, *w_router, *b_router, *w_eg, *w_eu, *w_ed, *g_final;
    float* out;
};
#define WSP(T, off) ((T*)(F.ws + (off)))

template <int ACT  >
__device__ __forceinline__ void store_tile_bf16(const pg8::f32x4 (&acc)[2][2][4][2], bf16* dst, int ld, int row0, int col0, float scale) {
#pragma unroll
    for (int ai = 0; ai < 2; ++ai)
#pragma unroll
        for (int m = 0; m < 4; ++m) { bf16* rowp = dst + (size_t)(row0 + ai * 128 + m * 16) * ld + col0;
#pragma unroll
            for (int bj = 0; bj < 2; ++bj) { pg8::f32x4 v0 = acc[ai][bj][m][0], v1 = acc[ai][bj][m][1];
                if (ACT == 1) {
#pragma unroll
                    for (int j = 0; j < 4; ++j) { v0[j] = fgelu_tanh(v0[j]); v1[j] = fgelu_tanh(v1[j]); } }
                if (ACT == 2) {
#pragma unroll
                    for (int j = 0; j < 4; ++j) { v0[j] = fsilu(v0[j]); v1[j] = fsilu(v1[j]); } }
                if (ACT == 3) { v0 = v0 * scale; v1 = v1 * scale; }
                v4u w; w.x = pk2(v0[0], v0[1]); w.y = pk2(v0[2], v0[3]); w.z = pk2(v1[0], v1[1]); w.w = pk2(v1[2], v1[3]);
                *(v4u*)(rowp + bj * 128) = w; } }
}
struct EpiI1 {
    static constexpr bool PERM = true;
    bf16 *U, *V, *Q, *K, *VV;
    __device__ __forceinline__ bool operator()(pg8::f32x4 (&acc)[2][2][4][2], const pg8::Unit& u, int wr, int wc, int fr, int fq) const {
        const int row0 = u.pm * 256 + wr * 64 + fr, cl = wc * 32 + 8 * fq;
        if (u.pn < 4)       store_tile_bf16<1>(acc, U, 1024, row0, u.pn * 256 + cl, 1.f);
        else if (u.pn < 8)  store_tile_bf16<1>(acc, V, 1024, row0, (u.pn - 4) * 256 + cl, 1.f);
        else if (u.pn < 10) store_tile_bf16<3>(acc, Q, 512, row0, (u.pn - 8) * 256 + cl, 0.08838834764831845f);
        else if (u.pn < 12) store_tile_bf16<0>(acc, K, 512, row0, (u.pn - 10) * 256 + cl, 1.f);
        else                store_tile_bf16<0>(acc, VV, 1024, row0, (u.pn - 12) * 256 + cl, 1.f);
        return false;
    }
};
struct EpiI2 {
    static constexpr bool PERM = true;
    bf16 *R, *GR, *GB; const float* bb;
    __device__ __forceinline__ bool operator()(pg8::f32x4 (&acc)[2][2][4][2], const pg8::Unit& u, int wr, int wc, int fr, int fq) const {
        const int row0 = u.pm * 256 + wr * 64 + fr, cl = wc * 32 + 8 * fq;
        if (u.pn < 4) { store_tile_bf16<2>(acc, R, 1024, row0, u.pn * 256 + cl, 1.f); return false; }
        const int col0 = (u.pn - 4) * 128 + cl;
        pg8::f32x4 ba[2], bbv[2];
#pragma unroll
        for (int n = 0; n < 2; ++n) { ba[n] = *(const pg8::f32x4*)(bb + col0 + 4 * n); bbv[n] = *(const pg8::f32x4*)(bb + 1024 + col0 + 4 * n); }
#pragma unroll
        for (int ai = 0; ai < 2; ++ai)
#pragma unroll
            for (int m = 0; m < 4; ++m) { const size_t off = (size_t)(row0 + ai * 128 + m * 16) * 1024 + col0;
                float ra[8], sb[8];
#pragma unroll
                for (int n = 0; n < 2; ++n)
#pragma unroll
                    for (int j = 0; j < 4; ++j) { float xa = acc[ai][0][m][n][j] + ba[n][j], xb = acc[ai][1][m][n][j] + bbv[n][j];
                        xa = fminf(fmaxf(xa, -30.f), 30.f); xb = fminf(fmaxf(xb, -30.f), 30.f);
                        const float ea = 1.0f + __expf(-xa), eb = 1.0f + __expf(-xb);
                        ra[n * 4 + j] = eb * __builtin_amdgcn_rcpf(ea); sb[n * 4 + j] = __builtin_amdgcn_rcpf(eb); }
                v4u w; w.x = pk2(ra[0], ra[1]); w.y = pk2(ra[2], ra[3]); w.z = pk2(ra[4], ra[5]); w.w = pk2(ra[6], ra[7]);
                *(v4u*)(GR + off) = w;
                v4u w2; w2.x = pk2(sb[0], sb[1]); w2.y = pk2(sb[2], sb[3]); w2.z = pk2(sb[4], sb[5]); w2.w = pk2(sb[6], sb[7]);
                *(v4u*)(GB + off) = w2; }
        return false;
    }
};
struct EpiM1 {
    static constexpr bool PERM = true;
    const bf16 *GR, *GB; bf16* MB;
    __device__ __forceinline__ bool operator()(pg8::f32x4 (&acc)[2][2][4][2], const pg8::Unit& u, int wr, int wc, int fr, int fq) const {
        const int row0 = u.pm * 256 + wr * 64 + fr, col0 = u.pn * 256 + wc * 32 + 8 * fq;
        const bf16* Gs = u.sub ? GB : GR;
#pragma unroll
        for (int ai = 0; ai < 2; ++ai)
#pragma unroll
            for (int m = 0; m < 4; ++m) { const size_t off = (size_t)(row0 + ai * 128 + m * 16) * 1024 + col0;
#pragma unroll
                for (int bj = 0; bj < 2; ++bj) { const v4u g = *(const v4u*)(Gs + off + bj * 128);
                    pg8::f32x4 v0 = acc[ai][bj][m][0], v1 = acc[ai][bj][m][1];
                    v0[0] *= bf_lo(g.x); v0[1] *= bf_hi(g.x); v0[2] *= bf_lo(g.y); v0[3] *= bf_hi(g.y);
                    v1[0] *= bf_lo(g.z); v1[1] *= bf_hi(g.z); v1[2] *= bf_lo(g.w); v1[3] *= bf_hi(g.w);
                    if (u.sub) { v4u w; w.x = pk2(v0[0], v0[1]); w.y = pk2(v0[2], v0[3]); w.z = pk2(v1[0], v1[1]); w.w = pk2(v1[2], v1[3]); *(v4u*)(MB + off + bj * 128) = w; }
                    else { acc[ai][bj][m][0] = v0; acc[ai][bj][m][1] = v1; } } }
        return u.sub == 0;
    }
};
struct EpiM2 {
    static constexpr bool PERM = false;
    const float* xlat; const float* xctx; float* olat; float* octx; const float* mod;
    __device__ __forceinline__ bool operator()(pg8::f32x4 (&acc)[2][2][4][2], const pg8::Unit& u, int wr, int wc, int fr, int fq) const {
        const bool isctx = u.pm >= 128; const int pml = isctx ? u.pm - 128 : u.pm; const int mb = isctx ? 8 : (u.pm >> 4);
        const float* src = isctx ? xctx : xlat; float* dst = isctx ? octx : olat;
        const int row0 = pml * 256 + wr * 64 + fr, col0 = u.pn * 256 + wc * 32 + 4 * fq;
        const float* gt = mod + mb * 6144 + 2 * 1024;
        pg8::f32x4 gv[2][2];
#pragma unroll
        for (int bj = 0; bj < 2; ++bj)
#pragma unroll
            for (int n = 0; n < 2; ++n) gv[bj][n] = *(const pg8::f32x4*)(gt + col0 + bj * 128 + n * 16);
#pragma unroll
        for (int ai = 0; ai < 2; ++ai)
#pragma unroll
            for (int m = 0; m < 4; ++m) { const size_t off = (size_t)(row0 + ai * 128 + m * 16) * 1024 + col0;
#pragma unroll
                for (int bj = 0; bj < 2; ++bj)
#pragma unroll
                    for (int n = 0; n < 2; ++n) { const pg8::f32x4 xv = *(const pg8::f32x4*)(src + off + bj * 128 + n * 16);
                        *(pg8::f32x4*)(dst + off + bj * 128 + n * 16) = xv + gv[bj][n] * acc[ai][bj][m][n]; } }
        return false;
    }
};
struct EpiG1 {
    static constexpr bool PERM = true;
    bf16* HH;
    __device__ __forceinline__ bool operator()(pg8::f32x4 (&acc)[2][2][4][2], const pg8::Unit& u, int wr, int wc, int fr, int fq) const {
        const int row0 = u.pm * 256 + wr * 64 + fr, col0 = u.pn * 128 + wc * 32 + 8 * fq;
#pragma unroll
        for (int ai = 0; ai < 2; ++ai)
#pragma unroll
            for (int m = 0; m < 4; ++m) { float h[8];
#pragma unroll
                for (int n = 0; n < 2; ++n)
#pragma unroll
                    for (int j = 0; j < 4; ++j) h[n * 4 + j] = fsilu(acc[ai][0][m][n][j]) * acc[ai][1][m][n][j];
                v4u w; w.x = pk2(h[0], h[1]); w.y = pk2(h[2], h[3]); w.z = pk2(h[4], h[5]); w.w = pk2(h[6], h[7]);
                *(v4u*)(HH + (size_t)(row0 + ai * 128 + m * 16) * DEXP + col0) = w; }
        return false;
    }
};
struct EpiG2 {
    static constexpr bool PERM = true;
    bf16* Y;
    __device__ __forceinline__ bool operator()(pg8::f32x4 (&acc)[2][2][4][2], const pg8::Unit& u, int wr, int wc, int fr, int fq) const {
        store_tile_bf16<0>(acc, Y, 1024, u.pm * 256 + wr * 64 + fr, u.pn * 256 + wc * 32 + 8 * fq, 1.f);
        return false;
    }
};

__device__ __forceinline__ void tr_item(const float* src, int ld_src, int k0, int n0, bf16* dst, int ld_dst, int r0, LAS float* scr, int lane) {
#pragma unroll 8
    for (int i = 0; i < 32; ++i) { const int kk = 2 * i + (lane >> 5); scr[kk * 33 + (lane & 31)] = src[(size_t)(k0 + kk) * ld_src + n0 + (lane & 31)]; }
    LDS_WAIT(); asm volatile("" ::: "memory");
    const int c = lane & 7;
#pragma unroll
    for (int j = 0; j < 4; ++j) { const int n = (lane >> 3) + 8 * j; const LAS float* s = scr + (8 * c) * 33 + n;
        v4u o; o.x = pk2(s[0 * 33], s[1 * 33]); o.y = pk2(s[2 * 33], s[3 * 33]); o.z = pk2(s[4 * 33], s[5 * 33]); o.w = pk2(s[6 * 33], s[7 * 33]);
        *(v4u*)(dst + (size_t)(r0 + n) * ld_dst + k0 + 8 * c) = o; }
    LDS_WAIT(); asm volatile("" ::: "memory");
}
__device__ __forceinline__ void convert_experts(Ctx& F, int layer, int gw, int NGW) {
    LAS float* scr = (LAS float*)(F.lds + F.wave * 16384);
    bf16* WGU = WSP(bf16, WS_WGU); bf16* WD = WSP(bf16, WS_WD);
    constexpr int I_GU = 16 * 48, I_D = 24 * 32, PER_E = 2 * I_GU + I_D;
    for (int it = gw; it < NEXP * PER_E; it += NGW) {
        const int e = it / PER_E; int r = it % PER_E;
        if (r < 2 * I_GU) { const int up = r >= I_GU; if (up) r -= I_GU; const int kb = r / 48, nb = r % 48, n0 = nb * 32;
            const size_t so = ((size_t)layer * NEXP + e) * D * DEXP;
            if (up) tr_item(F.w_eu + so, DEXP, kb * 64, n0, WGU + (size_t)e * 3072 * 1024, 1024, (n0 >> 7) * 256 + 128 + (n0 & 127), scr, F.lane);
            else    tr_item(F.w_eg + so, DEXP, kb * 64, n0, WGU + (size_t)e * 3072 * 1024, 1024, (n0 >> 7) * 256 + (n0 & 127), scr, F.lane); }
        else { r -= 2 * I_GU; const int kb = r / 32, nb = r % 32;
            tr_item(F.w_ed + ((size_t)layer * NEXP + e) * DEXP * D, D, kb * 64, nb * 32, WD + (size_t)e * 1024 * DEXP, DEXP, nb * 32, scr, F.lane); }
    }
}
__device__ __forceinline__ void p0_prologue(Ctx& F) {
    if (F.blk < 192) {
        LAS float* SC = (LAS float*)F.lds;
        LAS float* PART = (LAS float*)(F.lds + 40960);
        for (int i = F.tid; i < 9 * 1024; i += NTHR) { const float v = i < 8192 ? F.c[i] : F.c_ctx[i - 8192]; SC[i] = fsilu(v); }
        __syncthreads();
        const int l = F.blk / 96, jg = F.blk % 96, j = jg * 64 + F.lane;
        const float* W = F.w_mod + (size_t)l * D * 6144 + j;
        float acc[9];
#pragma unroll
        for (int r = 0; r < 9; ++r) acc[r] = 0.f;
        const int k0 = F.wave * 128;
#pragma unroll 8
        for (int k = k0; k < k0 + 128; ++k) { const float w = W[(size_t)k * 6144];
#pragma unroll
            for (int r = 0; r < 9; ++r) acc[r] += SC[r * 1024 + k] * w; }
#pragma unroll
        for (int r = 0; r < 9; ++r) PART[(F.wave * 9 + r) * 64 + F.lane] = acc[r];
        __syncthreads();
        float* MOD = WSP(float, WS_MOD);
        for (int idx = F.tid; idx < 576; idx += NTHR) { const int r = idx >> 6, cc = idx & 63; float s = F.b_mod[l * 6144 + jg * 64 + cc];
#pragma unroll
            for (int w = 0; w < 8; ++w) s += PART[(w * 9 + r) * 64 + cc];
            MOD[(size_t)(l * 9 + r) * 6144 + jg * 64 + cc] = s; }
        __syncthreads();
    }
    const int gw = F.blk * NWAVES + F.wave, NGW = F.G * NWAVES;
    LAS float* scr = (LAS float*)(F.lds + F.wave * 16384);
    {
        constexpr int PER_L = 2048 + 512 + 1024 + 3 * 512;
        for (int it = gw; it < 2 * PER_L; it += NGW) {
            const int l = it / PER_L; int r = it % PER_L;
            const float* win = F.w_in + (size_t)l * D * INCOLS;
            if (r < 2048) { const int kb = r / 128, nb = r % 128; tr_item(win, INCOLS, kb * 64, nb * 32, WSP(bf16, WS_W1T) + (size_t)l * 4096 * 1024, 1024, nb * 32, scr, F.lane); continue; } r -= 2048;
            if (r < 512) { const int kb = r / 32, nb = r % 32; tr_item(win, INCOLS, kb * 64, 4096 + nb * 32, WSP(bf16, WS_W2T) + (size_t)l * 3072 * 1024, 1024, nb * 32, scr, F.lane); continue; } r -= 512;
            if (r < 1024) { const int kb = r / 64, nb = r % 64; const int j0 = nb * 32; const int isb = j0 >= 1024; const int j = isb ? j0 - 1024 : j0;
                tr_item(win, INCOLS, kb * 64, 5152 + j0, WSP(bf16, WS_W2T) + (size_t)l * 3072 * 1024, 1024, 1024 + (j >> 7) * 256 + (isb ? 128 : 0) + (j & 127), scr, F.lane); continue; } r -= 1024;
            const int which = r / 512; r %= 512; const int kb = r / 32, nb = r % 32;
            const size_t lo_ = (size_t)l * D * D;
            if (which == 0)      tr_item(F.w_a + lo_, D, kb * 64, nb * 32, WSP(bf16, WS_WA) + lo_, D, nb * 32, scr, F.lane);
            else if (which == 1) tr_item(F.w_b + lo_, D, kb * 64, nb * 32, WSP(bf16, WS_WB) + lo_, D, nb * 32, scr, F.lane);
            else                 tr_item(F.w_out + lo_, D, kb * 64, nb * 32, WSP(bf16, WS_WO) + lo_, D, nb * 32, scr, F.lane);
        }
        unsigned* WLR = WSP(unsigned, WS_WLR);
        for (int i = F.blk * NTHR + F.tid; i < 2 * 512 * 32; i += F.G * NTHR) { const int l = i >> 14, kp = (i >> 5) & 511, cc = i & 31;
            const float* win = F.w_in + (size_t)l * D * INCOLS + 5120 + cc;
            WLR[i] = pk2(win[(size_t)(2 * kp) * INCOLS], win[(size_t)(2 * kp + 1) * INCOLS]); }
    }
    convert_experts(F, 0, gw, NGW);
}

template <int MODE>
__device__ __forceinline__ void phase_rows(Ctx& F, int lc  , int ln  ) {
    LAS unsigned* WL = (LAS unsigned*)F.lds;
    LAS unsigned* HS = (LAS unsigned*)(F.lds + 65536);
    const int nrows = (MODE == 2) ? NLAT : NTOK;
    if (MODE <= 1) { const unsigned* WLR = WSP(unsigned, WS_WLR) + ln * 16384; for (int i = F.tid; i < 16384; i += NTHR) WL[i] = WLR[i]; }
    __syncthreads();
    const float* MODn = WSP(float, WS_MOD) + (size_t)ln * 9 * 6144;
    const float* MODc = WSP(float, WS_MOD) + (size_t)lc * 9 * 6144;
    bf16* H = WSP(bf16, WS_H); const bf16* Y = WSP(bf16, WS_XG); float* LR = WSP(float, WS_LR); float* CTXS = WSP(float, WS_CTXS);
    const int* SPOS = WSP(int, WS_SPOS); const float* WGT = WSP(float, WS_WGT);
    const int ngroups = nrows / 16;
    for (int gi = F.blk; gi < ngroups; gi += F.G) {
#pragma unroll 1
        for (int rr = 0; rr < 2; ++rr) {
            const int rl = F.wave * 2 + rr, m = gi * 16 + rl;
            const int mb = m < NLAT ? (m >> 12) : 8;
            f32x4 v[4];
            if (MODE == 0) { const float* xr = (m < NLAT) ? F.x + (size_t)m * D : F.ctx + (size_t)(m - NLAT) * D;
#pragma unroll
                for (int j = 0; j < 4; ++j) v[j] = *(const f32x4*)(xr + 4 * F.lane + 256 * j); }
            else { float* xr = (m < NLAT) ? F.out + (size_t)m * D : CTXS + (size_t)(m - NLAT) * D;
                const int p0 = SPOS[2 * m], p1 = SPOS[2 * m + 1]; const float w0 = WGT[2 * m], w1 = WGT[2 * m + 1];
                const float* gt2 = MODc + mb * 6144 + 5 * 1024;
#pragma unroll
                for (int j = 0; j < 4; ++j) { const int k = 4 * F.lane + 256 * j;
                    const f32x4 xv = *(const f32x4*)(xr + k); const f32x4 g = *(const f32x4*)(gt2 + k);
                    const v2u a = *(const v2u*)(Y + (size_t)p0 * D + k), b = *(const v2u*)(Y + (size_t)p1 * D + k);
                    f32x4 y; y[0] = w0 * bf_lo(a.x) + w1 * bf_lo(b.x); y[1] = w0 * bf_hi(a.x) + w1 * bf_hi(b.x); y[2] = w0 * bf_lo(a.y) + w1 * bf_lo(b.y); y[3] = w0 * bf_hi(a.y) + w1 * bf_hi(b.y);
                    v[j] = xv + g * y;
                    if (MODE == 1) *(f32x4*)(xr + k) = v[j]; } }
            float ss = 0.f;
#pragma unroll
            for (int j = 0; j < 4; ++j) ss += (v[j][0] * v[j][0] + v[j][1] * v[j][1]) + (v[j][2] * v[j][2] + v[j][3] * v[j][3]);
            const float rstd = rsqrtf(wave_sum(ss) * (1.0f / D) + EPS);
            if (MODE == 2) {
#pragma unroll
                for (int j = 0; j < 4; ++j) { const int k = 4 * F.lane + 256 * j; const f32x4 g = *(const f32x4*)(F.g_final + k);
                    *(f32x4*)(F.out + (size_t)m * D + k) = v[j] * rstd * g; } }
            else {
                const float* g1 = F.g1 + ln * D; const float* sh = MODn + mb * 6144; const float* sc = sh + 1024;
#pragma unroll
                for (int j = 0; j < 4; ++j) { const int k = 4 * F.lane + 256 * j;
                    const f32x4 g = *(const f32x4*)(g1 + k), s1 = *(const f32x4*)(sc + k), s0 = *(const f32x4*)(sh + k);
                    const f32x4 hv = v[j] * rstd * g * (s1 + 1.0f) + s0;
                    v2u o; o.x = pk2(hv[0], hv[1]); o.y = pk2(hv[2], hv[3]);
                    *(v2u*)(H + (size_t)m * D + k) = o;
                    *(LAS v2u*)(HS + rl * 512 + (k >> 1)) = o; } }
        }
        if (MODE <= 1) {
            __syncthreads();
            const int r = F.tid >> 5, cc = F.tid & 31; float acc = 0.f;
#pragma unroll 8
            for (int kp = 0; kp < 512; ++kp) { const unsigned hv = HS[r * 512 + kp], wv = WL[kp * 32 + cc]; acc += bf_lo(hv) * bf_lo(wv) + bf_hi(hv) * bf_hi(wv); }
            LR[(size_t)(gi * 16 + r) * 32 + cc] = acc;
            __syncthreads();
        }
    }
}

typedef short s16x8 __attribute__((ext_vector_type(8)));
typedef short s16x4 __attribute__((ext_vector_type(4)));
typedef float f32x16 __attribute__((ext_vector_type(16)));
typedef __bf16 bf16x2_t __attribute__((ext_vector_type(2)));
#define MFMA32(a, b, c) __builtin_amdgcn_mfma_f32_32x32x16_bf16((a), (b), (c), 0, 0, 0)
__device__ __forceinline__ unsigned pkc(float a, float b) { f32x2 v = {a, b}; bf16x2_t r = __builtin_convertvector(v, bf16x2_t); return __builtin_bit_cast(unsigned, r); }
__device__ __forceinline__ int crow(int reg, int h) { return (reg & 3) + 8 * (reg >> 2) + 4 * h; }
__device__ __forceinline__ s16x8 pack_step(const f32x16& x, int s) {
    v4u p; p.x = pkc(x[8 * s], x[8 * s + 1]); p.y = pkc(x[8 * s + 2], x[8 * s + 3]); p.z = pkc(x[8 * s + 4], x[8 * s + 5]); p.w = pkc(x[8 * s + 6], x[8 * s + 7]);
    return __builtin_bit_cast(s16x8, p);
}
__device__ __forceinline__ void phase_gla(Ctx& F, int l) {
    LAS unsigned char* L = F.lds;
    LAS bf16* QS = (LAS bf16*)(L);
    LAS bf16* KS = (LAS bf16*)(L + 17408);
    LAS bf16* KT = (LAS bf16*)(L + 34816);
    LAS bf16* VT = (LAS bf16*)(L + 53248);
    LAS bf16* ST = (LAS bf16*)(L + 62464);
    LAS float* SEG = (LAS float*)(L + 97280);
    LAS float* EBL = (LAS float*)(L + 99328);
    LAS float* LRS = (LAS float*)(L + 99840);
    const bf16* Qb = WSP(bf16, WS_Q); const bf16* Kb = WSP(bf16, WS_K); const bf16* Vb = WSP(bf16, WS_VV); const float* LR = WSP(float, WS_LR);
    const int tid = F.tid, lane = F.lane, w = F.wave, r = lane & 31, h = lane >> 5;
    const int seg = w >> 1, kk = (w & 1) * 64 + lane;
    for (int u = F.blk; u < 256; u += F.G) {
        const int sl = u & 3, dir = (u >> 2) & 1, hd = (u >> 3) & 3, b = u >> 5;
        bf16* O = WSP(bf16, dir ? WS_OB : WS_OF);
        __syncthreads();
        float w2[16];
#pragma unroll
        for (int q = 0; q < 16; ++q) w2[q] = F.w_gate2[((size_t)(l * 2 + dir) * 16 + q) * 512 + hd * 128 + kk];
        const float bz = F.b_gate2[(l * 2 + dir) * 512 + hd * 128 + kk];
        for (int i = tid; i < 4352; i += NTHR) ((LAS unsigned*)ST)[i] = 0u;
        f32x16 sacc[2];
#pragma unroll
        for (int q = 0; q < 16; ++q) { sacc[0][q] = 0.f; sacc[1][q] = 0.f; }
        bf16 qreg[16], kreg[16]; v4u vreg; f32x2 lrreg;
#define GLA_TOK(base, i) ((base) + (dir ? 63 - (i) : (i)))
#define GLA_BASE(s) ((s) < 4 ? NLAT + b * CTXL + (dir ? 3 - (s) : (s)) * 64 : b * SEQ + (dir ? 63 - ((s) - 4) : ((s) - 4)) * 64)
#define GLA_LOAD(s) do { const int base_ = GLA_BASE(s); \
        _Pragma("unroll") for (int q = 0; q < 16; ++q) { const size_t t_ = (size_t)GLA_TOK(base_, 16 * seg + q); qreg[q] = Qb[t_ * 512 + hd * 128 + kk]; kreg[q] = Kb[t_ * 512 + hd * 128 + kk]; } \
        { const int i = tid >> 3, c8 = (tid & 7) * 8; vreg = *(const v4u*)(Vb + (size_t)GLA_TOK(base_, i) * 1024 + hd * 256 + sl * 64 + c8); } \
        { const int idx = tid * 2, i = idx >> 4, q = idx & 15; lrreg = *(const f32x2*)(LR + (size_t)GLA_TOK(base_, i) * 32 + dir * 16 + q); } } while (0)
        GLA_LOAD(0);
#pragma unroll 1
        for (int s = 0; s < 68; ++s) {
            const int base = GLA_BASE(s);
            LAS bf16* STc = ST + (s & 1) * (64 * 136); LAS bf16* STn = ST + ((s + 1) & 1) * (64 * 136);
            { const int idx = tid * 2; LRS[idx] = lrreg[0]; LRS[idx + 1] = lrreg[1]; }
            __syncthreads();
            float p[16]; float run = 0.f;
#pragma unroll
            for (int q = 0; q < 16; ++q) { const int i = 16 * seg + q; float z = bz;
#pragma unroll
                for (int r4 = 0; r4 < 4; ++r4) { const f32x4 lv = *(const LAS f32x4*)(LRS + i * 16 + r4 * 4); z += lv[0] * w2[r4 * 4] + lv[1] * w2[r4 * 4 + 1] + lv[2] * w2[r4 * 4 + 2] + lv[3] * w2[r4 * 4 + 3]; }
                run += (fminf(z, 0.f) - __logf(1.0f + __expf(-fabsf(z)))) * 0.0625f; p[q] = run; }
            SEG[seg * 128 + kk] = run;
            __syncthreads();
            float off = 0.f, tot = 0.f;
#pragma unroll
            for (int s2 = 0; s2 < 4; ++s2) { const float v = SEG[s2 * 128 + kk]; tot += v; off += (s2 < seg) ? v : 0.f; }
            if (seg == 0) EBL[kk] = __expf(tot);
            { unsigned ktp[8];
#pragma unroll
              for (int q = 0; q < 16; q += 2) { const float b0 = p[q] + off, b1 = p[q + 1] + off;
                  const float q0 = bf1(qreg[q]) * __expf(b0), q1 = bf1(qreg[q + 1]) * __expf(b1);
                  const float k0 = bf1(kreg[q]) * __expf(-b0), k1 = bf1(kreg[q + 1]) * __expf(-b1);
                  const unsigned qp = pkc(q0, q1), kp = pkc(k0, k1);
                  QS[(16 * seg + q) * 136 + kk] = (bf16)(qp & 0xffffu); QS[(16 * seg + q + 1) * 136 + kk] = (bf16)(qp >> 16);
                  KS[(16 * seg + q) * 136 + kk] = (bf16)(kp & 0xffffu); KS[(16 * seg + q + 1) * 136 + kk] = (bf16)(kp >> 16);
                  ktp[q >> 1] = kp; }
              v4u t0, t1; t0.x = ktp[0]; t0.y = ktp[1]; t0.z = ktp[2]; t0.w = ktp[3]; t1.x = ktp[4]; t1.y = ktp[5]; t1.z = ktp[6]; t1.w = ktp[7];
              *(LAS v4u*)(KT + kk * 72 + 16 * seg) = t0; *(LAS v4u*)(KT + kk * 72 + 16 * seg + 8) = t1; }
            { const int sr = tid >> 3, j8 = (tid & 7) * 8;
              VT[(j8 + 0) * 72 + sr] = (bf16)(vreg.x & 0xffffu); VT[(j8 + 1) * 72 + sr] = (bf16)(vreg.x >> 16); VT[(j8 + 2) * 72 + sr] = (bf16)(vreg.y & 0xffffu); VT[(j8 + 3) * 72 + sr] = (bf16)(vreg.y >> 16);
              VT[(j8 + 4) * 72 + sr] = (bf16)(vreg.z & 0xffffu); VT[(j8 + 5) * 72 + sr] = (bf16)(vreg.z >> 16); VT[(j8 + 6) * 72 + sr] = (bf16)(vreg.w & 0xffffu); VT[(j8 + 7) * 72 + sr] = (bf16)(vreg.w >> 16); }
            if (s + 1 < 68) GLA_LOAD(s + 1);
            __syncthreads();
            if (w < 4) {
                const int it = w >> 1, jt = w & 1;
                f32x16 o;
#pragma unroll
                for (int q = 0; q < 16; ++q) o[q] = 0.f;
#pragma unroll
                for (int st = 0; st < 2; ++st) if (st <= it) {
                    f32x16 x;
#pragma unroll
                    for (int q = 0; q < 16; ++q) x[q] = 0.f;
#pragma unroll
                    for (int ks = 0; ks < 8; ++ks) { const s16x8 a = *(const LAS s16x8*)(KS + (32 * st + r) * 136 + 16 * ks + 8 * h); const s16x8 bq = *(const LAS s16x8*)(QS + (32 * it + r) * 136 + 16 * ks + 8 * h); x = MFMA32(a, bq, x); }
                    if (st == it) {
#pragma unroll
                        for (int q = 0; q < 16; ++q) x[q] = (crow(q, h) <= r) ? x[q] : 0.f; }
#pragma unroll
                    for (int sp = 0; sp < 2; ++sp) { const s16x8 a = pack_step(x, sp);
                        const s16x4 lo = *(const LAS s16x4*)(VT + (32 * jt + r) * 72 + 32 * st + 16 * sp + 4 * h), hi = *(const LAS s16x4*)(VT + (32 * jt + r) * 72 + 32 * st + 16 * sp + 8 + 4 * h);
                        const s16x8 bv = __builtin_shufflevector(lo, hi, 0, 1, 2, 3, 4, 5, 6, 7);
                        o = MFMA32(a, bv, o); }
                }
#pragma unroll
                for (int ks = 0; ks < 8; ++ks) { const s16x8 a = *(const LAS s16x8*)(QS + (32 * it + r) * 136 + 16 * ks + 8 * h); const s16x8 bs = *(const LAS s16x8*)(STc + (32 * jt + r) * 136 + 16 * ks + 8 * h); o = MFMA32(a, bs, o); }
#pragma unroll
                for (int q = 0; q < 16; q += 2) { const unsigned pp = pkc(o[q], o[q + 1]);
                    O[(size_t)GLA_TOK(base, 32 * it + crow(q, h)) * 1024 + hd * 256 + sl * 64 + 32 * jt + r] = (bf16)(pp & 0xffffu);
                    O[(size_t)GLA_TOK(base, 32 * it + crow(q + 1, h)) * 1024 + hd * 256 + sl * 64 + 32 * jt + r] = (bf16)(pp >> 16); }
            } else {
                const int kt = w - 4;
#pragma unroll
                for (int jt = 0; jt < 2; ++jt) {
#pragma unroll
                    for (int ks = 0; ks < 4; ++ks) { const s16x8 a = *(const LAS s16x8*)(KT + (32 * kt + r) * 72 + 16 * ks + 8 * h); const s16x8 bv = *(const LAS s16x8*)(VT + (32 * jt + r) * 72 + 16 * ks + 8 * h); sacc[jt] = MFMA32(a, bv, sacc[jt]); }
#pragma unroll
                    for (int g = 0; g < 4; ++g) { const f32x4 e4 = *(const LAS f32x4*)(EBL + 32 * kt + 8 * g + 4 * h);
                        sacc[jt][4 * g] *= e4[0]; sacc[jt][4 * g + 1] *= e4[1]; sacc[jt][4 * g + 2] *= e4[2]; sacc[jt][4 * g + 3] *= e4[3];
                        v2u pk; pk.x = pkc(sacc[jt][4 * g], sacc[jt][4 * g + 1]); pk.y = pkc(sacc[jt][4 * g + 2], sacc[jt][4 * g + 3]);
                        *(LAS v2u*)(STn + (32 * jt + r) * 136 + 32 * kt + 8 * g + 4 * h) = pk; }
                }
            }
        }
#undef GLA_LOAD
#undef GLA_BASE
#undef GLA_TOK
    }
}

__device__ __forceinline__ void phase_sgu(Ctx& F, int l, int nrows) {
    LAS bf16* WB = (LAS bf16*)F.lds;
    LAS bf16* TT = (LAS bf16*)(F.lds + 34816);
    LAS float* MU = (LAS float*)(F.lds + 69632);
    LAS float* RSD = MU + 128;
    bf16* U = WSP(bf16, WS_U); const bf16* V = WSP(bf16, WS_V);
    const int lane = F.lane, w = F.wave, tid = F.tid, r = lane & 31, h = lane >> 5;
    const int nunits = (nrows / 128) * 8;
    for (int unit = F.blk; unit < nunits; unit += F.G) {
        const int c = unit >> 3, g = unit & 7, row0 = c * 128;
        __syncthreads();
        for (int i = 0; i < 16; ++i) { const int s = w * 16 + i; const bf16* vr = V + (size_t)(row0 + s) * 1024;
            const v4u a = *(const v4u*)(vr + lane * 8), b = *(const v4u*)(vr + 512 + lane * 8);
            float sm = 0.f, sq = 0.f;
#define SGU_ACC(u_) { const float x0 = bf_lo(u_), x1 = bf_hi(u_); sm += x0 + x1; sq += x0 * x0 + x1 * x1; }
            SGU_ACC(a.x) SGU_ACC(a.y) SGU_ACC(a.z) SGU_ACC(a.w) SGU_ACC(b.x) SGU_ACC(b.y) SGU_ACC(b.z) SGU_ACC(b.w)
#undef SGU_ACC
            sm = wave_sum(sm); sq = wave_sum(sq);
            const float mean = sm * (1.0f / 1024.0f); const float var = fmaxf(sq * (1.0f / 1024.0f) - mean * mean, 0.f);
            if (lane == 0) { MU[s] = mean; RSD[s] = rsqrtf(var + EPS); } }
        const float* wsrc = F.sgu_w + (size_t)(l * 8 + g) * 16384;
#pragma unroll
        for (int j = 0; j < 8; ++j) { const int p = tid + 512 * j, t = p >> 5, s4 = (p & 31) * 4; const f32x4 wv = *(const f32x4*)(wsrc + p * 4);
            v2u o; o.x = pkc(wv[0], wv[1]); o.y = pkc(wv[2], wv[3]); *(LAS v2u*)(WB + t * 136 + s4) = o; }
        __syncthreads();
        const float* lng = F.ln_g + l * 1024 + g * 128; const float* lnb = F.ln_b + l * 1024 + g * 128;
#pragma unroll
        for (int j = 0; j < 4; ++j) { const int p = tid + 512 * j, s = p >> 4, c8 = (p & 15) * 8;
            const v4u a = *(const v4u*)(V + (size_t)(row0 + s) * 1024 + g * 128 + c8);
            const f32x4 g0 = *(const f32x4*)(lng + c8), g1 = *(const f32x4*)(lng + c8 + 4), b0 = *(const f32x4*)(lnb + c8), b1 = *(const f32x4*)(lnb + c8 + 4);
            const float mu = MU[s], rs = RSD[s];
            TT[(c8 + 0) * 136 + s] = f2bf((bf_lo(a.x) - mu) * rs * g0[0] + b0[0]); TT[(c8 + 1) * 136 + s] = f2bf((bf_hi(a.x) - mu) * rs * g0[1] + b0[1]);
            TT[(c8 + 2) * 136 + s] = f2bf((bf_lo(a.y) - mu) * rs * g0[2] + b0[2]); TT[(c8 + 3) * 136 + s] = f2bf((bf_hi(a.y) - mu) * rs * g0[3] + b0[3]);
            TT[(c8 + 4) * 136 + s] = f2bf((bf_lo(a.z) - mu) * rs * g1[0] + b1[0]); TT[(c8 + 5) * 136 + s] = f2bf((bf_hi(a.z) - mu) * rs * g1[1] + b1[1]);
            TT[(c8 + 6) * 136 + s] = f2bf((bf_lo(a.w) - mu) * rs * g1[2] + b1[2]); TT[(c8 + 7) * 136 + s] = f2bf((bf_hi(a.w) - mu) * rs * g1[3] + b1[3]); }
        __syncthreads();
        const int tt = w >> 1;
        const float* bs = F.sgu_b + (l * 8 + g) * 128;
#pragma unroll
        for (int cc = 0; cc < 2; ++cc) { const int ct = 2 * (w & 1) + cc;
            f32x16 acc;
#pragma unroll
            for (int q = 0; q < 16; ++q) acc[q] = 0.f;
#pragma unroll
            for (int ks = 0; ks < 8; ++ks) { const s16x8 a = *(const LAS s16x8*)(WB + (32 * tt + r) * 136 + 16 * ks + 8 * h); const s16x8 bt = *(const LAS s16x8*)(TT + (32 * ct + r) * 136 + 16 * ks + 8 * h); acc = MFMA32(a, bt, acc); }
#pragma unroll
            for (int q = 0; q < 16; ++q) { const int t = 32 * tt + crow(q, h); bf16* up = U + (size_t)(row0 + t) * 1024 + g * 128 + 32 * ct + r; *up = f2bf(bf1(*up) * (acc[q] + bs[t])); } }
    }
}

__device__ __forceinline__ void phase_ob(Ctx& F, int l, int nrows) {
    const bf16* OFp = WSP(bf16, WS_OF); const bf16* OBp = WSP(bf16, WS_OB); bf16* R = WSP(bf16, WS_R);
    const float* gg = F.gla_g + l * 1024 + F.lane * 16;
    f32x4 g4[4];
#pragma unroll
    for (int j = 0; j < 4; ++j) g4[j] = *(const f32x4*)(gg + 4 * j);
    for (int m = F.blk * NWAVES + F.wave; m < nrows; m += F.G * NWAVES) {
        const size_t off = (size_t)m * 1024 + F.lane * 16;
        const v4u a0 = *(const v4u*)(OFp + off), a1 = *(const v4u*)(OFp + off + 8), b0 = *(const v4u*)(OBp + off), b1 = *(const v4u*)(OBp + off + 8);
        const v4u r0 = *(const v4u*)(R + off), r1 = *(const v4u*)(R + off + 8);
        float o[16];
#define OB_SUM(i_, ua, ub) o[i_] = bf_lo(ua) + bf_lo(ub); o[i_ + 1] = bf_hi(ua) + bf_hi(ub);
        OB_SUM(0, a0.x, b0.x) OB_SUM(2, a0.y, b0.y) OB_SUM(4, a0.z, b0.z) OB_SUM(6, a0.w, b0.w) OB_SUM(8, a1.x, b1.x) OB_SUM(10, a1.y, b1.y) OB_SUM(12, a1.z, b1.z) OB_SUM(14, a1.w, b1.w)
#undef OB_SUM
        float ss = 0.f;
#pragma unroll
        for (int i = 0; i < 16; ++i) ss += o[i] * o[i];
        ss += __shfl_xor(ss, 1); ss += __shfl_xor(ss, 2); ss += __shfl_xor(ss, 4); ss += __shfl_xor(ss, 8);
        const float rn = rsqrtf(ss * (1.0f / 256.0f) + EPS);
        float rv[16];
        rv[0] = bf_lo(r0.x); rv[1] = bf_hi(r0.x); rv[2] = bf_lo(r0.y); rv[3] = bf_hi(r0.y); rv[4] = bf_lo(r0.z); rv[5] = bf_hi(r0.z); rv[6] = bf_lo(r0.w); rv[7] = bf_hi(r0.w);
        rv[8] = bf_lo(r1.x); rv[9] = bf_hi(r1.x); rv[10] = bf_lo(r1.y); rv[11] = bf_hi(r1.y); rv[12] = bf_lo(r1.z); rv[13] = bf_hi(r1.z); rv[14] = bf_lo(r1.w); rv[15] = bf_hi(r1.w);
#pragma unroll
        for (int i = 0; i < 16; ++i) o[i] = o[i] * rn * g4[i >> 2][i & 3] * rv[i];
        v4u w0, w1; w0.x = pk2(o[0], o[1]); w0.y = pk2(o[2], o[3]); w0.z = pk2(o[4], o[5]); w0.w = pk2(o[6], o[7]);
        w1.x = pk2(o[8], o[9]); w1.y = pk2(o[10], o[11]); w1.z = pk2(o[12], o[13]); w1.w = pk2(o[14], o[15]);
        *(v4u*)(R + off) = w0; *(v4u*)(R + off + 8) = w1;
    }
}

__device__ __forceinline__ void phase_router(Ctx& F, int l, int nrows) {
    LAS float* WR = (LAS float*)F.lds;
    LAS int* HIST = (LAS int*)(F.lds + 65536);
    for (int i = F.tid; i < 16384; i += NTHR) { const int k = i >> 4, e = i & 15; WR[e * 1024 + k] = F.w_router[i]; }
    if (F.tid < 16) HIST[F.tid] = 0;
    __syncthreads();
    const float* MODl = WSP(float, WS_MOD) + (size_t)l * 9 * 6144; const float* g2 = F.g2 + l * D;
    bf16* H2 = WSP(bf16, WS_H2); int* EID = WSP(int, WS_EID); float* WGT = WSP(float, WS_WGT); const float* CTXS = WSP(float, WS_CTXS);
    const int rpb = (nrows + F.G - 1) / F.G, r_lo = F.blk * rpb, r_hi = (r_lo + rpb < nrows) ? r_lo + rpb : nrows;
    for (int m = r_lo + F.wave; m < r_hi; m += NWAVES) {
        const int mb = m < NLAT ? (m >> 12) : 8;
        const float* xr = (m < NLAT) ? F.out + (size_t)m * D : CTXS + (size_t)(m - NLAT) * D;
        const float* sh = MODl + mb * 6144 + 3 * 1024; const float* sc = sh + 1024;
        f32x4 v[4]; float ss = 0.f;
#pragma unroll
        for (int j = 0; j < 4; ++j) { v[j] = *(const f32x4*)(xr + 4 * F.lane + 256 * j); ss += (v[j][0] * v[j][0] + v[j][1] * v[j][1]) + (v[j][2] * v[j][2] + v[j][3] * v[j][3]); }
        const float rstd = rsqrtf(wave_sum(ss) * (1.0f / D) + EPS);
#pragma unroll
        for (int j = 0; j < 4; ++j) { const int k = 4 * F.lane + 256 * j;
            const f32x4 g = *(const f32x4*)(g2 + k), s1 = *(const f32x4*)(sc + k), s0 = *(const f32x4*)(sh + k);
            v[j] = v[j] * rstd * g * (s1 + 1.0f) + s0;
            v2u o; o.x = pk2(v[j][0], v[j][1]); o.y = pk2(v[j][2], v[j][3]);
            *(v2u*)(H2 + (size_t)m * D + k) = o; }
        float lg[16];
#pragma unroll
        for (int e = 0; e < 16; ++e) { float p = 0.f;
#pragma unroll
            for (int j = 0; j < 4; ++j) { const f32x4 wv = *(const LAS f32x4*)(WR + e * 1024 + 4 * F.lane + 256 * j); p += (v[j][0] * wv[0] + v[j][1] * wv[1]) + (v[j][2] * wv[2] + v[j][3] * wv[3]); }
            lg[e] = wave_sum(p) + F.b_router[e]; }
        float mx = lg[0];
#pragma unroll
        for (int e = 1; e < 16; ++e) mx = fmaxf(mx, lg[e]);
        float p[16];
#pragma unroll
        for (int e = 0; e < 16; ++e) p[e] = __expf(lg[e] - mx);
        int gsel = 0; float gbest = -1.f;
#pragma unroll
        for (int g = 0; g < 4; ++g) { const float a = p[4 * g], b = p[4 * g + 1], c = p[4 * g + 2], d = p[4 * g + 3];
            const float hi1 = fmaxf(a, b), lo1 = fminf(a, b), hi2 = fmaxf(c, d), lo2 = fminf(c, d);
            const float top = fmaxf(hi1, hi2), second = fmaxf(fminf(hi1, hi2), fmaxf(lo1, lo2));
            const float sc_ = top + second; if (sc_ > gbest) { gbest = sc_; gsel = g; } }
        float q[4];
#pragma unroll
        for (int i = 0; i < 4; ++i) q[i] = gsel == 0 ? p[i] : gsel == 1 ? p[4 + i] : gsel == 2 ? p[8 + i] : p[12 + i];
        int i1 = 0; float p1 = q[0];
#pragma unroll
        for (int i = 1; i < 4; ++i) if (q[i] > p1) { p1 = q[i]; i1 = i; }
        int i2 = -1; float p2 = -1.f;
#pragma unroll
        for (int i = 0; i < 4; ++i) if (i != i1 && q[i] > p2) { p2 = q[i]; i2 = i; }
        const float inv = 1.0f / (p1 + p2);
        if (F.lane == 0) { EID[2 * m] = gsel * 4 + i1; EID[2 * m + 1] = gsel * 4 + i2; WGT[2 * m] = p1 * inv; WGT[2 * m + 1] = p2 * inv;
            atomicAdd((int*)(HIST + gsel * 4 + i1), 1); atomicAdd((int*)(HIST + gsel * 4 + i2), 1); }
    }
    __syncthreads();
    if (F.tid < 16) WSP(int, WS_HISTG)[F.blk * 16 + F.tid] = HIST[F.tid];
}

__device__ __forceinline__ void phase_scatter(Ctx& F, int nrows) {
    LAS int* CNT = (LAS int*)F.lds;
    LAS int* BASE = CNT + 16;
    LAS int* PST = CNT + 32;
    LAS int* ES = CNT + 64;
    LAS int* POS = CNT + 64 + 1024;
    const int* HISTG = WSP(int, WS_HISTG); const int* EID = WSP(int, WS_EID); int* SPOS = WSP(int, WS_SPOS); int* TILEE = WSP(int, WS_TILEE);
    __syncthreads();
    if (F.tid < 16) { int tot = 0, mine = 0; for (int b = 0; b < F.G; ++b) { const int v = HISTG[b * 16 + F.tid]; tot += v; if (b < F.blk) mine += v; } CNT[F.tid] = tot; BASE[F.tid] = mine; }
    __syncthreads();
    if (F.tid == 0) { int p = 0; for (int e = 0; e < 16; ++e) { PST[e] = p; const int nt = (CNT[e] + 255) >> 8;
            if (F.blk == 0) for (int t = 0; t < nt; ++t) TILEE[16 + (p >> 8) + t] = e;
            p += nt << 8; }
        if (F.blk == 0) TILEE[0] = p >> 8; }
    const int rpb = (nrows + F.G - 1) / F.G, r_lo = F.blk * rpb, r_hi = (r_lo + rpb < nrows) ? r_lo + rpb : nrows;
    const int nslots = (r_hi > r_lo) ? 2 * (r_hi - r_lo) : 0;
    for (int q = F.tid; q < nslots; q += NTHR) ES[q] = EID[2 * r_lo + q];
    __syncthreads();
    for (int q = F.tid; q < nslots; q += NTHR) { const int e = ES[q]; int rank = 0; for (int q2 = 0; q2 < q; ++q2) rank += (ES[q2] == e) ? 1 : 0;
        const int pos = PST[e] + BASE[e] + rank; POS[q] = pos; SPOS[2 * r_lo + q] = pos; }
    __syncthreads();
    const bf16* H2 = WSP(bf16, WS_H2); bf16* XG = WSP(bf16, WS_XG);
    for (int q = F.wave; q < nslots; q += NWAVES) { const bf16* src = H2 + (size_t)(r_lo + (q >> 1)) * D + F.lane * 16; bf16* dst = XG + (size_t)POS[q] * D + F.lane * 16;
        const v4u a = *(const v4u*)src, b = *(const v4u*)(src + 8); *(v4u*)dst = a; *(v4u*)(dst + 8) = b; }
}

typedef __attribute__((address_space(4))) const unsigned char* KARGP;
__device__ __forceinline__ unsigned long long karg_q(int off) { asm volatile("" : "+s"(off)); return *(const __attribute__((address_space(4))) unsigned long long*)((KARGP)__builtin_amdgcn_kernarg_segment_ptr() + off); }
__device__ __forceinline__ Ctx mk_ctx(LAS unsigned char* lds) {
    Ctx F; F.lds = lds; F.ws = (unsigned char*)(GAS unsigned char*)karg_q(27 * 8); F.out = (float*)(GAS float*)karg_q(26 * 8);
    F.tid = opaque_v((int)threadIdx.x); F.lane = F.tid & 63; F.wave = __builtin_amdgcn_readfirstlane(F.tid >> 6); F.G = gridDim.x; F.blk = blockIdx.x;
#define KIN(k) ((const float*)(GAS const float*)karg_q((k) * 8))
    F.x = KIN(0); F.c = KIN(1); F.ctx = KIN(2); F.c_ctx = KIN(3); F.w_mod = KIN(4); F.b_mod = KIN(5); F.g1 = KIN(6); F.g2 = KIN(7);
    F.w_in = KIN(8); F.w_gate2 = KIN(9); F.b_gate2 = KIN(10); F.gla_g = KIN(11); F.ln_g = KIN(12); F.ln_b = KIN(13); F.sgu_w = KIN(14); F.sgu_b = KIN(15);
    F.w_a = KIN(16); F.w_b = KIN(17); F.b_branch = KIN(18); F.w_out = KIN(19); F.w_router = KIN(20); F.b_router = KIN(21);
    F.w_eg = KIN(22); F.w_eu = KIN(23); F.w_ed = KIN(24); F.g_final = KIN(25);
#undef KIN
    return F;
}
struct Args { const float* in[26]; float* out; unsigned char* ws; int ph_lo, ph_hi; };
constexpr int NPHASE = 2 + 12 * DEPTH;

#if MK_SPLIT
#define GRID_BAR() do { } while (0)
#else
#define GRID_BAR() do { XcdBarrier b_ = bar; asm volatile("" : "+s"(b_.x)); unsigned long long p_ = (unsigned long long)b_.bar; asm volatile("" : "+s"(p_)); b_.bar = (unsigned*)(GAS unsigned*)p_; xcd_barrier(b_); } while (0)
#endif
#ifndef PH_KIND
#define PH_KIND (-1)
#endif
#define KON(j) (PH_KIND < 0 || PH_KIND == (j))
#define IN(k) (lo <= (k) && (k) < hi)
#define SEAM(k) do { if (IN(k) && IN((k) + 1)) GRID_BAR(); } while (0)
template <int l>
__device__ __forceinline__ void layer_body(LAS unsigned char* const ldsb, const int lo, const int hi, const XcdBarrier& bar) {

        const int pb = 2 + 12 * l;
        const bool wctx = l < DEPTH - 1;
        const int nrow_m = wctx ? NTOK : NLAT;
        if (KON(0) && IN(pb + 0)) { Ctx F = mk_ctx(ldsb); LAS unsigned char* ring = F.lds;
            pg8::SchedPlain S; S.o.init(NTOK / 256, 16, F.G, F.blk); S.A = (const char*)WSP(bf16, WS_H); S.B = (const char*)(WSP(bf16, WS_W1T) + (size_t)l * 4096 * 1024); S.tstep = (size_t)256 * 1024 * 2;
            EpiI1 E{WSP(bf16, WS_U), WSP(bf16, WS_V), WSP(bf16, WS_Q), WSP(bf16, WS_K), WSP(bf16, WS_VV)};
            pg8::gemm_phase<EpiI1, pg8::SchedPlain, true, true>(ring, 1024, S, E);
        } SEAM(pb + 0);
        if (KON(1) && IN(pb + 1)) { Ctx F = mk_ctx(ldsb); LAS unsigned char* ring = F.lds; phase_gla(F, l); } SEAM(pb + 1);
        if (KON(2) && IN(pb + 2)) { Ctx F = mk_ctx(ldsb); LAS unsigned char* ring = F.lds; phase_sgu(F, l, nrow_m); } SEAM(pb + 2);
        if (KON(3) && IN(pb + 3)) { Ctx F = mk_ctx(ldsb); LAS unsigned char* ring = F.lds;
            pg8::SchedPlain S; S.o.init(nrow_m / 256, 12, F.G, F.blk); S.A = (const char*)WSP(bf16, WS_H); S.B = (const char*)(WSP(bf16, WS_W2T) + (size_t)l * 3072 * 1024); S.tstep = (size_t)256 * 1024 * 2;
            EpiI2 E{WSP(bf16, WS_R), WSP(bf16, WS_GR), WSP(bf16, WS_GB), F.b_branch + l * 2048};
            pg8::gemm_phase<EpiI2, pg8::SchedPlain, true, true>(ring, 1024, S, E);
        } SEAM(pb + 3);
        if (KON(4) && IN(pb + 4)) { Ctx F = mk_ctx(ldsb); LAS unsigned char* ring = F.lds; phase_ob(F, l, nrow_m); } SEAM(pb + 4);
        if (KON(5) && IN(pb + 5)) { Ctx F = mk_ctx(ldsb); LAS unsigned char* ring = F.lds;
            pg8::SchedDual S; S.o.init(nrow_m / 256, 4, F.G, F.blk); S.tstep = (size_t)256 * 1024 * 2;
            S.A0 = (const char*)WSP(bf16, WS_U); S.B0 = (const char*)(WSP(bf16, WS_WA) + (size_t)l * D * D);
            S.A1 = (const char*)WSP(bf16, WS_R); S.B1 = (const char*)(WSP(bf16, WS_WB) + (size_t)l * D * D);
            EpiM1 E{WSP(bf16, WS_GR), WSP(bf16, WS_GB), WSP(bf16, WS_MB)};
            pg8::gemm_phase<EpiM1, pg8::SchedDual, true, true>(ring, 1024, S, E);
        } SEAM(pb + 5);
        if (KON(6) && IN(pb + 6)) { Ctx F = mk_ctx(ldsb); LAS unsigned char* ring = F.lds;
            pg8::SchedPlain S; S.o.init(nrow_m / 256, 4, F.G, F.blk); S.A = (const char*)WSP(bf16, WS_MB); S.B = (const char*)(WSP(bf16, WS_WO) + (size_t)l * D * D); S.tstep = (size_t)256 * 1024 * 2;
            EpiM2 E{l == 0 ? F.x : F.out, l == 0 ? F.ctx : WSP(float, WS_CTXS), F.out, WSP(float, WS_CTXS), WSP(float, WS_MOD) + (size_t)l * 9 * 6144};
            pg8::gemm_phase<EpiM2, pg8::SchedPlain, true, true>(ring, 1024, S, E);
        } SEAM(pb + 6);
        if (KON(7) && IN(pb + 7)) { Ctx F = mk_ctx(ldsb); LAS unsigned char* ring = F.lds; phase_router(F, l, nrow_m); } SEAM(pb + 7);
        if (KON(8) && IN(pb + 8)) { Ctx F = mk_ctx(ldsb); LAS unsigned char* ring = F.lds; phase_scatter(F, nrow_m); } SEAM(pb + 8);
        if (KON(9) && IN(pb + 9)) { Ctx F = mk_ctx(ldsb); LAS unsigned char* ring = F.lds;
            const int* TILEE = WSP(int, WS_TILEE); const int ntiles = TILEE[0];
            pg8::SchedMoe S; S.o.init(ntiles, 12, F.G, F.blk); S.A = (const char*)WSP(bf16, WS_XG); S.B = (const char*)WSP(bf16, WS_WGU); S.tstep = (size_t)256 * 1024 * 2; S.estride = (size_t)3072 * 1024 * 2; S.tile_e = TILEE + 16;
            EpiG1 E{WSP(bf16, WS_HH)};
            pg8::gemm_phase<EpiG1, pg8::SchedMoe, true, true>(ring, 1024, S, E);
        } SEAM(pb + 9);
        if (KON(10) && IN(pb + 10)) { Ctx F = mk_ctx(ldsb); LAS unsigned char* ring = F.lds;
            const int* TILEE = WSP(int, WS_TILEE); const int ntiles = TILEE[0];
            pg8::SchedMoe S; S.o.init(ntiles, 4, F.G, F.blk); S.A = (const char*)WSP(bf16, WS_HH); S.B = (const char*)WSP(bf16, WS_WD); S.tstep = (size_t)256 * DEXP * 2; S.estride = (size_t)1024 * DEXP * 2; S.tile_e = TILEE + 16;
            EpiG2 E{WSP(bf16, WS_XG)};
            pg8::gemm_phase<EpiG2, pg8::SchedMoe, true, true>(ring, DEXP, S, E);
        } SEAM(pb + 10);
        if (KON(11) && IN(pb + 11)) { Ctx F = mk_ctx(ldsb); LAS unsigned char* ring = F.lds;
            if (wctx) { phase_rows<1>(F, l, l + 1); __syncthreads(); convert_experts(F, l + 1, F.blk * NWAVES + F.wave, F.G * NWAVES); }
            else phase_rows<2>(F, l, l);
        }
        if (l + 1 < DEPTH) SEAM(pb + 11);
    }
__global__ void __launch_bounds__(NTHR, 2) mega_fwd(Args args) {
    extern __shared__ __attribute__((aligned(16))) unsigned char lds[];
    LAS unsigned char* const ldsb = (LAS unsigned char*)lds;
    volatile LAS unsigned* MISC = (volatile LAS unsigned*)(ldsb + MISC_OFF);
    if (threadIdx.x < 64) MISC[threadIdx.x] = 0u;
    __syncthreads();
    unsigned* ctl = (unsigned*)(args.ws + WS_CTL);
#if MK_SPLIT
    XcdBarrier bar; bar.bar = ctl + CW_BAR; bar.x = 0; bar.st = MISC + 8;
#else
    XcdBarrier bar = xcd_barrier_post(ctl + CW_BAR, MISC + 8);
#endif
    const int lo = args.ph_lo, hi = args.ph_hi;

    if (KON(12) && IN(0)) { Ctx F = mk_ctx(ldsb); p0_prologue(F); } SEAM(0);
    if (KON(13) && IN(1)) { Ctx F = mk_ctx(ldsb); phase_rows<0>(F, 0, 0); } SEAM(1);

    layer_body<0>(ldsb, lo, hi, bar);
    layer_body<1>(ldsb, lo, hi, bar);
#undef IN
#undef SEAM
}

extern "C" void kernel_launch(void* const* d_in, const int* in_sizes, int n_in, void* d_out, int out_size, void* d_ws, size_t ws_size, hipStream_t stream) {
    static int grid = 0;
    if (grid == 0) {
        if (n_in != 26 || in_sizes[0] != NLAT * D || out_size != NLAT * D || ws_size < WS_END) { fprintf(stderr, "kernel_launch: unexpected problem (n_in %d, ws %zu < %zu)\n", n_in, ws_size, (size_t)WS_END); grid = -1; return; }
        int dev = 0, cus = 0;
        if (hipGetDevice(&dev) != hipSuccess || hipDeviceGetAttribute(&cus, hipDeviceAttributeMultiprocessorCount, dev) != hipSuccess) { grid = -1; return; }
        if (hipFuncSetAttribute((const void*)mega_fwd, hipFuncAttributeMaxDynamicSharedMemorySize, LDS_BYTES) != hipSuccess) { fprintf(stderr, "kernel_launch: hipFuncSetAttribute failed\n"); grid = -1; return; }
        int per_cu = 0;
        if (hipOccupancyMaxActiveBlocksPerMultiprocessor(&per_cu, (const void*)mega_fwd, NTHR, LDS_BYTES) != hipSuccess || per_cu < 1) fprintf(stderr, "kernel_launch: occupancy query reports %d\n", per_cu);
        (void)hipGetLastError();
        grid = cus;
    }
    if (grid < 0) return;
    if (hipMemsetAsync((char*)d_ws + WS_CTL, 0, CTL_ZERO_BYTES, stream) != hipSuccess) return;
    Args a{};
    for (int i = 0; i < 26; ++i) a.in[i] = (const float*)d_in[i];
    a.out = (float*)d_out; a.ws = (unsigned char*)d_ws;
#if MK_SPLIT
    for (int p = 0; p < NPHASE; ++p) { a.ph_lo = p; a.ph_hi = p + 1; hipLaunchKernelGGL(mega_fwd, dim3(grid), dim3(NTHR), LDS_BYTES, stream, a); }
#else
    a.ph_lo = 0; a.ph_hi = NPHASE;
    hipLaunchKernelGGL(mega_fwd, dim3(grid), dim3(NTHR), LDS_BYTES, stream, a);
#endif
}
```
